# Optimizing an MI355X kernel written in HIP

```python
import math
import jax, jax.numpy as jnp
from jax import lax
import numpy as np

D_MODEL = 1024
BATCH = 4
SEQ = 8192
DEPTH = 2

HEAD_DIM = 64
A_HEADS = D_MODEL // 256
A_VDIM = 2 * HEAD_DIM
A_QK_WIDTH = A_HEADS * 2 * HEAD_DIM
A_V_WIDTH = A_HEADS * A_VDIM
B_HEADS = D_MODEL // 128
B_WIDTH = B_HEADS * HEAD_DIM
IN_WIDTH = 2 * A_QK_WIDTH + A_V_WIDTH + 3 * B_WIDTH
MIX_WIDTH = A_V_WIDTH + B_WIDTH
D_FF = 2816
GRID_W = 64
NA_ROWS = 8
NA_COLS = 16
POOL_WINDOWS = (2, 4, 8, 16)
POOL_GROUPS = 4
POOL_GROUP_DIM = D_MODEL // POOL_GROUPS
ROPE_THETA = 10000.0
Q_BLOCK = 128
EPS = 1e-6
N_MOD = 9
N_EVEN = (DEPTH + 1) // 2
N_ODD = DEPTH // 2
NEG_INF = -1e30

kernel_name = "hybrid_diffattn_natten_pool_macaron_adaln"


def rmsnorm(x, g):
    xf = x.astype(jnp.float32)
    y = xf * lax.rsqrt(jnp.mean(xf * xf, axis=-1, keepdims=True) + EPS)
    return (y * g.astype(jnp.float32)).astype(x.dtype)


def modulate(h, shift, scale):
    return h * (1 + scale[:, None, :]) + shift[:, None, :]


def swiglu(h, w13, w2):
    a, b = jnp.split(h @ w13, 2, axis=-1)
    return (jax.nn.silu(a) * b) @ w2


def rope(x, pos):
    d = x.shape[-1]
    inv = ROPE_THETA ** (-jnp.arange(0, d, 2, dtype=jnp.float32) / d)
    ang = pos.astype(jnp.float32)[:, None] * inv[None, :]
    cos = jnp.cos(ang).astype(x.dtype)
    sin = jnp.sin(ang).astype(x.dtype)
    x1, x2 = x[..., : d // 2], x[..., d // 2:]
    return jnp.concatenate([x1 * cos - x2 * sin, x1 * sin + x2 * cos], axis=-1)


def diff_attention(q, k, v, qk_norm, lam_params, subln_g, lambda_init):
    B_, S, H, _, d = q.shape
    pos = jnp.arange(S)
    q = rope(rmsnorm(q, qk_norm[0]).transpose(0, 2, 3, 1, 4), pos)
    k = rope(rmsnorm(k, qk_norm[1]).transpose(0, 2, 3, 1, 4), pos)
    v = v.transpose(0, 2, 1, 3)
    lp = lam_params.astype(jnp.float32)
    lam = jnp.exp(jnp.sum(lp[0] * lp[1])) - jnp.exp(jnp.sum(lp[2] * lp[3])) + lambda_init
    scale = d ** -0.5
    nb = S // Q_BLOCK
    qb = q.reshape(B_, H, 2, nb, Q_BLOCK, d).transpose(3, 0, 1, 2, 4, 5)

    def block(qblk):
        s = jnp.einsum('bhmqd,bhmkd->bhmqk', qblk, k).astype(jnp.float32) * scale
        p = jax.nn.softmax(s, axis=-1)
        w = p[:, :, 0] - lam * p[:, :, 1]
        return jnp.einsum('bhqk,bhkv->bhqv', w.astype(v.dtype), v)

    o = lax.map(block, qb)
    o = o.transpose(1, 0, 3, 2, 4).reshape(B_, S, H, 2 * d)
    o = rmsnorm(o, subln_g) * (1.0 - lambda_init)
    return o.reshape(B_, S, H * 2 * d)


def neighbourhood_attention(q, k, v, qk_norm, rpb):
    B_, S, H, d = q.shape
    rows = S // GRID_W
    kr = min(NA_ROWS, rows)
    q = rmsnorm(q, qk_norm[0])
    k = rmsnorm(k, qk_norm[1])

    def to_grid(t):
        return t.reshape(B_, rows, GRID_W, H, d).transpose(1, 0, 3, 2, 4)

    qg, kg, vg = to_grid(q), to_grid(k), to_grid(v)
    col = jnp.arange(GRID_W)
    col_start = jnp.clip(col - NA_COLS // 2, 0, GRID_W - NA_COLS)
    col_in = (col[None, :] >= col_start[:, None]) & (col[None, :] < col_start[:, None] + NA_COLS)
    dc_idx = jnp.clip(col[None, :] - col[:, None] + NA_COLS - 1, 0, 2 * NA_COLS - 2)
    scale = d ** -0.5

    def row_block(args):
        qr, r = args
        rs = jnp.clip(r - kr // 2, 0, rows - kr)
        kb = lax.dynamic_slice_in_dim(kg, rs, kr, axis=0)
        vb = lax.dynamic_slice_in_dim(vg, rs, kr, axis=0)
        s = jnp.einsum('bhqd,rbhkd->bhqrk', qr, kb).astype(jnp.float32) * scale
        dr_idx = rs + jnp.arange(kr) - r + NA_ROWS - 1
        bias = rpb[:, dr_idx][:, :, dc_idx].transpose(0, 2, 1, 3)
        s = s + bias[None].astype(jnp.float32)
        s = jnp.where(col_in[:, None, :], s, NEG_INF)
        p = jax.nn.softmax(s.reshape(B_, H, GRID_W, kr * GRID_W), axis=-1)
        p = p.reshape(B_, H, GRID_W, kr, GRID_W).astype(vb.dtype)
        return jnp.einsum('bhqrk,rbhkd->bhqd', p, vb)

    o = lax.map(row_block, (qg, jnp.arange(rows)))
    return o.transpose(1, 0, 3, 2, 4).reshape(B_, S, H * d)


def even_mixer(h, w_in, w_out, a_qk_norm, a_lambda, a_subln, b_qk_norm, b_rpb, lambda_init):
    B_, S, _ = h.shape
    u = h @ w_in
    qa, ka, va, qb, kb, vb = jnp.split(u, 6, axis=-1)
    oa = diff_attention(qa.reshape(B_, S, A_HEADS, 2, HEAD_DIM),
                        ka.reshape(B_, S, A_HEADS, 2, HEAD_DIM),
                        va.reshape(B_, S, A_HEADS, A_VDIM),
                        a_qk_norm, a_lambda, a_subln, lambda_init)
    ob = neighbourhood_attention(qb.reshape(B_, S, B_HEADS, HEAD_DIM),
                                 kb.reshape(B_, S, B_HEADS, HEAD_DIM),
                                 vb.reshape(B_, S, B_HEADS, HEAD_DIM),
                                 b_qk_norm, b_rpb)
    return jnp.concatenate([oa, ob], axis=-1) @ w_out


def multiscale_pool(h, w_grp, b_grp, scale):
    B_, S, D = h.shape
    hf = h.astype(jnp.float32)
    cs = jnp.concatenate([jnp.zeros((B_, 1, D), jnp.float32), jnp.cumsum(hf, axis=1)], axis=1)
    t = jnp.arange(S)
    outs = []
    for g, w in enumerate(POOL_WINDOWS):
        lo = jnp.clip(t - w // 2, 0, S)
        hi = jnp.clip(t - w // 2 + w, 0, S)
        csg = cs[:, :, g * POOL_GROUP_DIM:(g + 1) * POOL_GROUP_DIM]
        seg = jnp.take(csg, hi, axis=1) - jnp.take(csg, lo, axis=1)
        outs.append(seg / (hi - lo).astype(jnp.float32)[None, :, None])
    pooled = jnp.concatenate(outs, axis=-1)
    y = (pooled - hf).astype(h.dtype).reshape(B_, S, POOL_GROUPS, POOL_GROUP_DIM)
    y = jnp.einsum('bsgi,gio->bsgo', y, w_grp).reshape(B_, S, D) + b_grp
    return y * scale


def setup_inputs(seed: int = 0) -> dict:
    key = jax.random.key(seed)
    ks = jax.random.split(key, 17)

    def nrm(k, shape, s):
        return jax.random.normal(k, shape, jnp.float32) * s

    return {
        "x": nrm(ks[0], (BATCH, SEQ, D_MODEL), 1.0),
        "c": nrm(ks[1], (BATCH, D_MODEL), 1.0),
        "ada_w": nrm(ks[2], (DEPTH, D_MODEL, N_MOD * D_MODEL), 0.02),
        "ada_b": nrm(ks[3], (DEPTH, N_MOD * D_MODEL), 0.02),
        "norm_g": 1.0 + nrm(ks[4], (DEPTH, 3, D_MODEL), 0.02),
        "ff_w13": nrm(ks[5], (DEPTH, 2, D_MODEL, 2 * D_FF), D_MODEL ** -0.5),
        "ff_w2": nrm(ks[6], (DEPTH, 2, D_FF, D_MODEL), D_FF ** -0.5),
        "w_in": nrm(ks[7], (N_EVEN, D_MODEL, IN_WIDTH), D_MODEL ** -0.5),
        "w_out": nrm(ks[8], (N_EVEN, MIX_WIDTH, D_MODEL), MIX_WIDTH ** -0.5),
        "a_qk_norm": 1.0 + nrm(ks[9], (N_EVEN, 2, HEAD_DIM), 0.02),
        "a_lambda": nrm(ks[10], (N_EVEN, 4, HEAD_DIM), 0.1),
        "a_subln": 1.0 + nrm(ks[11], (N_EVEN, A_VDIM), 0.02),
        "b_qk_norm": 1.0 + nrm(ks[12], (N_EVEN, 2, HEAD_DIM), 0.02),
        "b_rpb": nrm(ks[13], (N_EVEN, B_HEADS, 2 * NA_ROWS - 1, 2 * NA_COLS - 1), 0.1),
        "pool_w": nrm(ks[14], (N_ODD, POOL_GROUPS, POOL_GROUP_DIM, POOL_GROUP_DIM), POOL_GROUP_DIM ** -0.5),
        "pool_b": nrm(ks[15], (N_ODD, D_MODEL), 0.02),
        "pool_scale": 1.0 + nrm(ks[16], (N_ODD, D_MODEL), 0.1),
    }


def reference(x, c, ada_w, ada_b, norm_g, ff_w13, ff_w2, w_in, w_out, a_qk_norm, a_lambda,
              a_subln, b_qk_norm, b_rpb, pool_w, pool_b, pool_scale):
    B_, S, D = x.shape
    cond = jax.nn.silu(c)
    for layer in range(DEPTH):
        mod = (cond @ ada_w[layer] + ada_b[layer]).reshape(B_, N_MOD, D)
        sh1, sc1, g1, sh2, sc2, g2, sh3, sc3, g3 = [mod[:, i] for i in range(N_MOD)]
        h = modulate(rmsnorm(x, norm_g[layer, 0]), sh1, sc1)
        x = x + 0.5 * g1[:, None, :] * swiglu(h, ff_w13[layer, 0], ff_w2[layer, 0])
        h = modulate(rmsnorm(x, norm_g[layer, 1]), sh2, sc2)
        if layer % 2 == 0:
            e = layer // 2
            lambda_init = 0.8 - 0.6 * math.exp(-0.3 * layer)
            mix = even_mixer(h, w_in[e], w_out[e], a_qk_norm[e], a_lambda[e], a_subln[e],
                             b_qk_norm[e], b_rpb[e], lambda_init)
        else:
            o = layer // 2
            mix = multiscale_pool(h, pool_w[o], pool_b[o], pool_scale[o])
        x = x + g2[:, None, :] * mix
        h = modulate(rmsnorm(x, norm_g[layer, 2]), sh3, sc3)
        x = x + 0.5 * g3[:, None, :] * swiglu(h, ff_w13[layer, 1], ff_w2[layer, 1])
    return x
```

```cpp
#include <hip/hip_runtime.h>
#include <hip/hip_cooperative_groups.h>
#include <cstdio>
#include <cstdint>
namespace cg = cooperative_groups;

#ifndef DBG
#define DBG 0
#endif
#ifndef MEGA
#define MEGA 1
#endif

#define DEVI __device__ __forceinline__
typedef unsigned short bf16_t;
typedef float f32x4 __attribute__((ext_vector_type(4)));
typedef unsigned u32x4 __attribute__((ext_vector_type(4)));
typedef unsigned u32x2 __attribute__((ext_vector_type(2)));

constexpr int DM = 1024, NBATCH = 4, SEQ = 8192, T = NBATCH * SEQ, DFF = 2816, INW = 3072;
constexpr float EPS = 1e-6f, LOG2E = 1.4426950408889634f, C2 = 0.125f * LOG2E;
constexpr int NTHR = 512;

constexpr size_t MiB = 1u << 20;
constexpr size_t WS_MODP = 0, WS_MOD = 3 * MiB, WS_ROPE = 4 * MiB, WS_W13T = 6 * MiB, WS_W2T = 50 * MiB, WS_WINT = 72 * MiB, WS_WOUTT = 78 * MiB,
                 WS_POOLT = 80 * MiB, WS_H = 82 * MiB, WS_ACT = 146 * MiB, WS_OA = 338 * MiB, WS_END = 466 * MiB;
constexpr size_t WS_SS = 2359296, WS_CB = WS_MOD + 589824, WS_H2 = WS_OA;
constexpr size_t WS_XB = WS_OA + 64 * MiB;
constexpr size_t WS_BAR = 81 * MiB;
constexpr size_t WS_DBGW = WS_MOD + 512 * 1024;
constexpr size_t W13T_ELEMS = (size_t)2 * DFF * DM, W2T_ELEMS = (size_t)DM * DFF;

struct P {
    const float *x, *c, *ada_w, *ada_b, *norm_g, *ff_w13, *ff_w2, *w_in, *w_out, *a_qk_norm, *a_lambda, *a_subln, *b_qk_norm, *b_rpb, *pool_w, *pool_b, *pool_scale;
    float* out; unsigned char* ws;
};

DEVI int tid_opaque() { int t = threadIdx.x; asm volatile("" : "+v"(t)); return t; }
DEVI float bf2f(unsigned v) { return __uint_as_float(v << 16); }
DEVI float bflo(unsigned w) { return __uint_as_float(w << 16); }
DEVI float bfhi(unsigned w) { return __uint_as_float(w & 0xffff0000u); }
DEVI unsigned f2bf(float f) { unsigned u = __float_as_uint(f); return (u + 0x7fffu + ((u >> 16) & 1u)) >> 16; }
DEVI unsigned pk2(float lo, float hi) { return f2bf(lo) | (f2bf(hi) << 16); }
template <int M> DEVI float swz_xor(float v) { static_assert(M > 0 && M < 32, "ds_swizzle bit mode works inside 32-lane halves"); return __int_as_float(__builtin_amdgcn_ds_swizzle(__float_as_int(v), 0x1f | (M << 10))); }
DEVI float add32(float v) { const auto rr = __builtin_amdgcn_permlane32_swap(__float_as_uint(v), __float_as_uint(v), false, false); return __uint_as_float(rr[0]) + __uint_as_float(rr[1]); }
DEVI float max32(float v) { const auto rr = __builtin_amdgcn_permlane32_swap(__float_as_uint(v), __float_as_uint(v), false, false); return fmaxf(__uint_as_float(rr[0]), __uint_as_float(rr[1])); }
DEVI float wave_sum(float v) { v += swz_xor<1>(v); v += swz_xor<2>(v); v += swz_xor<4>(v); v += swz_xor<8>(v); v += swz_xor<16>(v); return add32(v); }
DEVI float wave_max(float v) { v = fmaxf(v, swz_xor<1>(v)); v = fmaxf(v, swz_xor<2>(v)); v = fmaxf(v, swz_xor<4>(v)); v = fmaxf(v, swz_xor<8>(v)); v = fmaxf(v, swz_xor<16>(v)); return max32(v); }
DEVI float siluf(float a) { return a / (1.f + __expf(-a)); }
DEVI const float* modptr(const P& p, int layer, int b, int m) { return (const float*)(p.ws + WS_MOD) + ((size_t)(layer * 4 + b) * 9 + m) * 1024; }

constexpr int MODP_KC = 7, MODP_KLEN = 147;
DEVI void ph_modp(const P& p, float* lds, int bid, int nb) {
    float* modp = (float*)(p.ws + WS_MODP);
#if DBG
    if (bid == 0 && tid_opaque() < 2) ((unsigned*)(p.ws + WS_DBGW))[tid_opaque()] = 0u;
#endif
    for (int i = tid_opaque(); i < 4096; i += NTHR) lds[i] = siluf(p.c[i]);
    { f32x4* ssz = (f32x4*)(p.ws + WS_SS) + T / 4; for (int i = bid * NTHR + tid_opaque(); i < 4 * T / 4; i += nb * NTHR) ssz[i] = (f32x4){0.f, 0.f, 0.f, 0.f}; }
    __syncthreads();
    const int total = 2 * MODP_KC * 9216;
    for (int i = bid * NTHR + tid_opaque(); i < total; i += nb * NTHR) {
        const int j = i % 9216, lk = i / 9216, l = lk / MODP_KC, kc = lk % MODP_KC;
        const int kb = kc * MODP_KLEN, ke = min(kb + MODP_KLEN, 1024);
        const float* w = p.ada_w + ((size_t)l * 1024 + kb) * 9216 + j;
        float a0 = 0.f, a1 = 0.f, a2 = 0.f, a3 = 0.f;
#pragma unroll 16
        for (int k = kb; k < ke; ++k) { const float wv = w[(size_t)(k - kb) * 9216];
            a0 += lds[k] * wv; a1 += lds[1024 + k] * wv; a2 += lds[2048 + k] * wv; a3 += lds[3072 + k] * wv; }
        float* o = modp + ((size_t)(kc * 2 + l) * 4) * 9216 + j;
        o[0] = a0; o[9216] = a1; o[2 * 9216] = a2; o[3 * 9216] = a3;
    }
}
DEVI void ph_modfinal(const P& p, int bid, int nb) {
    const float* modp = (const float*)(p.ws + WS_MODP); float* mod = (float*)(p.ws + WS_MOD);
    const int total = 2 * 4 * 9216;
    for (int i = bid * NTHR + tid_opaque(); i < total; i += nb * NTHR) {
        const int j = i % 9216, lb = i / 9216, l = lb >> 2, b = lb & 3;
        float s = p.ada_b[l * 9216 + j];
#pragma unroll
        for (int kc = 0; kc < MODP_KC; ++kc) s += modp[((size_t)(kc * 2 + l) * 4 + b) * 9216 + j];
        mod[i] = s;
    }
}
DEVI void ph_rope(const P& p, int bid, int nb) {
    float* rope = (float*)(p.ws + WS_ROPE);
    for (int i = bid * NTHR + tid_opaque(); i < SEQ * 32; i += nb * NTHR) {
        const int pos = i >> 5, f = i & 31;
        const float inv = powf(10000.f, -(float)(2 * f) / 64.f);
        const float ang = (float)pos * inv;
        rope[2 * i] = cosf(ang); rope[2 * i + 1] = sinf(ang);
    }
}
DEVI int map_id(int n) { return n; }
DEVI int map_w13(int n) { const int half = n >= DFF, nn = half ? n - DFF : n; return (nn >> 7) * 256 + half * 128 + (nn & 127); }
DEVI int map_win(int n) {
    const int sec = n >> 9; if (sec == 2 || sec == 5) return n;
    const int tile = n >> 8, w = n & 255, head = w >> 6, dim = w & 63; return tile * 256 + (dim >> 5) * 128 + head * 32 + (dim & 31);
}
template <int MAP> DEVI void transpose_item(const float* W, int K, int N, bf16_t* WT, float* scr, int item, int lane) {
    const int nblk = N / 32, kb = item / nblk, nbk = item % nblk, k0 = 64 * kb, n0 = 32 * nbk;
    float wv[32];
#pragma unroll
    for (int i = 0; i < 32; ++i) wv[i] = W[(size_t)(k0 + 2 * i + (lane >> 5)) * N + n0 + (lane & 31)];
#pragma unroll
    for (int i = 0; i < 32; ++i) scr[(2 * i + (lane >> 5)) * 33 + (lane & 31)] = wv[i];
    asm volatile("s_waitcnt lgkmcnt(0)" ::: "memory");
    const int c = lane & 7;
#pragma unroll
    for (int j = 0; j < 4; ++j) { const int n = (lane >> 3) + 8 * j; const float* s = scr + (8 * c) * 33 + n;
        u32x4 o; o.x = pk2(s[0 * 33], s[1 * 33]); o.y = pk2(s[2 * 33], s[3 * 33]); o.z = pk2(s[4 * 33], s[5 * 33]); o.w = pk2(s[6 * 33], s[7 * 33]);
        const int nn = n0 + n; const int row = MAP == 0 ? map_id(nn) : MAP == 1 ? map_w13(nn) : map_win(nn);
        *(u32x4*)(WT + (size_t)row * K + k0 + 8 * c) = o; }
    asm volatile("s_waitcnt lgkmcnt(0)" ::: "memory");
}
DEVI void ph_weights(const P& p, float* lds, int bid, int nb) {
    const int wave = tid_opaque() >> 6, lane = tid_opaque() & 63;
    float* scr = lds + wave * (64 * 33);
    const int gw = bid * 8 + wave, NGW = nb * 8;
    constexpr int I13 = (DM / 64) * (2 * DFF / 32), I2 = (DFF / 64) * (DM / 32), IIN = (DM / 64) * (INW / 32), IOUT = (DM / 64) * (DM / 32), IPL = (256 / 64) * (256 / 32);
    constexpr int NITEMS = 4 * I13 + 4 * I2 + IIN + IOUT + 4 * IPL;
    bf16_t* W13T = (bf16_t*)(p.ws + WS_W13T); bf16_t* W2T = (bf16_t*)(p.ws + WS_W2T);
    for (int it = gw; it < NITEMS; it += NGW) {
        int r = it;
        if (r < 4 * I13) { const int m = r / I13; transpose_item<1>(p.ff_w13 + (size_t)m * DM * 2 * DFF, DM, 2 * DFF, W13T + (size_t)m * W13T_ELEMS, scr, r % I13, lane); continue; } r -= 4 * I13;
        if (r < 4 * I2) { const int m = r / I2; transpose_item<0>(p.ff_w2 + (size_t)m * DFF * DM, DFF, DM, W2T + (size_t)m * W2T_ELEMS, scr, r % I2, lane); continue; } r -= 4 * I2;
        if (r < IIN) { transpose_item<2>(p.w_in, DM, INW, (bf16_t*)(p.ws + WS_WINT), scr, r, lane); continue; } r -= IIN;
        if (r < IOUT) { transpose_item<0>(p.w_out, DM, DM, (bf16_t*)(p.ws + WS_WOUTT), scr, r, lane); continue; } r -= IOUT;
        { const int g = r / IPL; transpose_item<0>(p.pool_w + (size_t)g * 65536, 256, 256, (bf16_t*)(p.ws + WS_POOLT) + (size_t)g * 65536, scr, r % IPL, lane); }
    }
}
DEVI void ph_norm(const P& p, const float* xin, int layer, int sub, int bid, int nb) {
    bf16_t* H = (bf16_t*)(p.ws + WS_H);
    const float* g = p.norm_g + (layer * 3 + sub) * 1024;
    const int wave = tid_opaque() >> 6, lane = tid_opaque() & 63;
    for (int row = bid * 8 + wave; row < T; row += nb * 8) {
        const int b = row / SEQ;
        const float* sh = modptr(p, layer, b, sub * 3 + 0); const float* sc = modptr(p, layer, b, sub * 3 + 1);
        const f32x4* xr = (const f32x4*)(xin + (size_t)row * DM) + lane;
        f32x4 v[4]; float ss = 0.f;
#pragma unroll
        for (int j = 0; j < 4; ++j) { v[j] = xr[64 * j]; ss += (v[j].x * v[j].x + v[j].y * v[j].y) + (v[j].z * v[j].z + v[j].w * v[j].w); }
        const float r = rsqrtf(wave_sum(ss) * (1.f / DM) + EPS);
        u32x2* o8 = (u32x2*)(H + (size_t)row * DM) + lane;
#pragma unroll
        for (int j = 0; j < 4; ++j) { const int c = 4 * lane + 256 * j;
            const f32x4 gv = *(const f32x4*)(g + c), sv = *(const f32x4*)(sc + c), hv = *(const f32x4*)(sh + c);
            const f32x4 y = (v[j] * r) * gv * (sv + 1.f) + hv;
            u32x2 w; w.x = pk2(y.x, y.y); w.y = pk2(y.z, y.w); o8[64 * j] = w; }
    }
}
DEVI void ph_norm0(const P& p, int bid, int nb) {
    bf16_t* H = (bf16_t*)(p.ws + WS_H); float* SS = (float*)(p.ws + WS_SS);
    const float* g = p.norm_g;
    const int wave = tid_opaque() >> 6, lane = tid_opaque() & 63;
    for (int row = bid * 8 + wave; row < T; row += nb * 8) {
        const int b = row / SEQ; const float* sc = modptr(p, 0, b, 1);
        const f32x4* xr = (const f32x4*)(p.x + (size_t)row * DM) + lane;
        f32x4 v[4]; float ss = 0.f;
#pragma unroll
        for (int j = 0; j < 4; ++j) { v[j] = xr[64 * j]; ss += (v[j].x * v[j].x + v[j].y * v[j].y) + (v[j].z * v[j].z + v[j].w * v[j].w); }
        ss = wave_sum(ss); if (lane == 0) SS[row] = ss;
        u32x2* o8 = (u32x2*)(H + (size_t)row * DM) + lane; u32x2* x8 = (u32x2*)((bf16_t*)(p.ws + WS_XB) + (size_t)row * DM) + lane;
#pragma unroll
        for (int j = 0; j < 4; ++j) { const int c = 4 * lane + 256 * j;
            const f32x4 y = v[j] * *(const f32x4*)(g + c) * (*(const f32x4*)(sc + c) + 1.f);
            u32x2 w; w.x = pk2(y.x, y.y); w.y = pk2(y.z, y.w); o8[64 * j] = w;
            u32x2 xw; xw.x = pk2(v[j].x, v[j].y); xw.y = pk2(v[j].z, v[j].w); x8[64 * j] = xw; }
    }
    float* CB = (float*)(p.ws + WS_CB);
    const int nrows = 4 * 2 * DFF + INW;
    for (int rw = bid * 8 + wave; rw < nrows; rw += nb * 8) {
        const bf16_t* wt; int layer, m, n, ostride; float* out;
        if (rw < 4 * 2 * DFF) { const int lf = rw / (2 * DFF); n = rw % (2 * DFF); wt = (const bf16_t*)(p.ws + WS_W13T) + (size_t)lf * W13T_ELEMS + (size_t)n * DM; layer = lf >> 1; m = (lf & 1) ? 6 : 0; out = CB + (size_t)lf * 4 * 2 * DFF + n; ostride = 2 * DFF; }
        else { n = rw - 4 * 2 * DFF; wt = (const bf16_t*)(p.ws + WS_WINT) + (size_t)n * DM; layer = 0; m = 3; out = CB + (size_t)16 * 2 * DFF + n; ostride = INW; }
        float a[4] = {0.f, 0.f, 0.f, 0.f};
#pragma unroll
        for (int j = 0; j < 2; ++j) { const int k = 8 * lane + 512 * j; const u32x4 w = *(const u32x4*)(wt + k);
            const float wf[8] = {bflo(w.x), bfhi(w.x), bflo(w.y), bfhi(w.y), bflo(w.z), bfhi(w.z), bflo(w.w), bfhi(w.w)};
#pragma unroll
            for (int b = 0; b < 4; ++b) { const float* sh = modptr(p, layer, b, m) + k; const f32x4 s0 = *(const f32x4*)sh, s1 = *(const f32x4*)(sh + 4);
                a[b] += (wf[0] * s0.x + wf[1] * s0.y) + (wf[2] * s0.z + wf[3] * s0.w) + (wf[4] * s1.x + wf[5] * s1.y) + (wf[6] * s1.z + wf[7] * s1.w); } }
#pragma unroll
        for (int b = 0; b < 4; ++b) { const float t = wave_sum(a[b]); if (lane == 0) out[(size_t)b * ostride] = t; }
    }
}
DEVI void ph_pool(const P& p, const float* xin, float* lds, int bid, int nb) {
    bf16_t* H = (bf16_t*)(p.ws + WS_H); const bf16_t* XB = (const bf16_t*)(p.ws + WS_XB);
    const float* gn = p.norm_g + (1 * 3 + 1) * 1024;
    const int tid = tid_opaque(), wave = tid >> 6, lane = tid & 63;
    float* rsq = lds; float* tile = lds + 128;
    for (int chunk = bid; chunk < T / 64; chunk += nb) {
        const int t0 = chunk * 64, b = t0 / SEQ, s0 = t0 % SEQ;
        __syncthreads();
        for (int i = wave; i < 80; i += 8) { const int s = s0 - 8 + i;
            if (s >= 0 && s < SEQ) { const u32x2* xr = (const u32x2*)(XB + ((size_t)b * SEQ + s) * DM) + lane; float ss = 0.f;
#pragma unroll
                for (int j = 0; j < 4; ++j) { const u32x2 w = xr[64 * j]; const f32x4 v = {bflo(w.x), bfhi(w.x), bflo(w.y), bfhi(w.y)}; ss += (v.x * v.x + v.y * v.y) + (v.z * v.z + v.w * v.w); }
                const float r = rsqrtf(wave_sum(ss) * (1.f / DM) + EPS); if (lane == 0) rsq[i] = r; }
            else if (lane == 0) rsq[i] = 0.f; }
        __syncthreads();
        const float* sc = modptr(p, 1, b, 4);
        for (int g = 0; g < 4; ++g) { const int hw = 1 << g;
#pragma unroll
            for (int k = 0; k < 10; ++k) { const int idx = tid + 512 * k, row = idx >> 6, c4 = idx & 63, s = s0 - 8 + row;
                f32x4 v = {0.f, 0.f, 0.f, 0.f};
                if (s >= 0 && s < SEQ) { const u32x2 w = *((const u32x2*)(XB + ((size_t)b * SEQ + s) * DM + g * 256) + c4); v = (f32x4){bflo(w.x), bfhi(w.x), bflo(w.y), bfhi(w.y)} * rsq[row]; }
                *(f32x4*)(tile + row * 256 + c4 * 4) = v; }
            __syncthreads();
            { const int c = tid & 255, i0 = (tid >> 8) * 32, cg = g * 256 + c;
              const float gg = gn[cg] * (1.f + sc[cg]);
              float S = 0.f;
              for (int k = -hw; k < hw; ++k) S += tile[(i0 + 8 + k) * 256 + c];
              for (int n = 0; n < 32; ++n) { const int idx = i0 + n + 8, sq = s0 + i0 + n; const int lo = max(sq - hw, 0), hi = min(sq + hw, SEQ);
                  const float y = gg * (S / (float)(hi - lo) - tile[idx * 256 + c]);
                  H[(size_t)(t0 + i0 + n) * DM + cg] = (bf16_t)f2bf(y);
                  S += tile[(idx + hw) * 256 + c] - tile[(idx - hw) * 256 + c]; } }
            __syncthreads();
        }
    }
}
struct EpiSwiglu { bf16_t* act; DEVI void operator()(int r, int c, float a, float b) const { act[(size_t)r * DFF + c] = (bf16_t)f2bf(siluf(a) * b); } };
struct EpiResid { const float* xin; float* xout; const float* mod; float coef; const float* bias; const float* scale; int layer, m;
    DEVI void operator()(int r, int c, float a, float) const { const int b = r / SEQ; const float g = mod[((size_t)(layer * 4 + b) * 9 + m) * 1024 + c];
        float v = a; if (bias) v = (v + bias[c]) * scale[c]; const size_t o = (size_t)r * DM + c; xout[o] = xin[o] + coef * g * v; } };
DEVI int unmap_win(int cb) { const int sec = cb >> 9; if (sec == 2 || sec == 5) return cb; const int tile = cb >> 8, w = cb & 255, bj = w >> 7, head = (w >> 5) & 3, j = w & 31; return tile * 256 + head * 64 + bj * 32 + j; }
struct EpiRawQKV { bf16_t* qkv; DEVI void operator()(int r, int c, float a, float) const { qkv[(size_t)r * INW + unmap_win(c)] = (bf16_t)f2bf(a); } };

template <int MODE, class Epi>
DEVI void ph_gemm_naive(const bf16_t* A, int lda, const bf16_t* Bt, int ldb, int M, int N, int K, const Epi& E, float* lds, int bid, int nb) {
    float* As = lds; float* Bs = lds + 32 * 132; float* Bs2 = Bs + 32 * 132;
    const int tid = tid_opaque(), ty = tid >> 5, tx = tid & 31;
    const int nN = N / 128, nM = M / 128;
    for (int tile = bid; tile < nM * nN; tile += nb) {
        const int pm = tile / nN, pn = tile % nN;
        const bf16_t* Ab = A + (size_t)pm * 128 * lda + (MODE == 2 ? (pn >> 1) * 256 : 0);
        const bf16_t* B1 = Bt + (size_t)(MODE == 1 ? pn * 256 : pn * 128) * ldb;
        const bf16_t* B2 = B1 + (size_t)128 * ldb;
        float acc[8][4], acc2[8][4];
#pragma unroll
        for (int i = 0; i < 8; ++i)
#pragma unroll
            for (int j = 0; j < 4; ++j) { acc[i][j] = 0.f; acc2[i][j] = 0.f; }
        for (int k0 = 0; k0 < K; k0 += 32) {
            __syncthreads();
            { const int row = tid >> 2, ks = (tid & 3) * 8;
              const u32x4 va = *(const u32x4*)(Ab + (size_t)row * lda + k0 + ks);
              float* d = As + ks * 132 + row;
              d[0] = bflo(va.x); d[132] = bfhi(va.x); d[2 * 132] = bflo(va.y); d[3 * 132] = bfhi(va.y); d[4 * 132] = bflo(va.z); d[5 * 132] = bfhi(va.z); d[6 * 132] = bflo(va.w); d[7 * 132] = bfhi(va.w);
              const u32x4 vb = *(const u32x4*)(B1 + (size_t)row * ldb + k0 + ks);
              d = Bs + ks * 132 + row;
              d[0] = bflo(vb.x); d[132] = bfhi(vb.x); d[2 * 132] = bflo(vb.y); d[3 * 132] = bfhi(vb.y); d[4 * 132] = bflo(vb.z); d[5 * 132] = bfhi(vb.z); d[6 * 132] = bflo(vb.w); d[7 * 132] = bfhi(vb.w);
              if (MODE == 1) { const u32x4 vc = *(const u32x4*)(B2 + (size_t)row * ldb + k0 + ks);
                  d = Bs2 + ks * 132 + row;
                  d[0] = bflo(vc.x); d[132] = bfhi(vc.x); d[2 * 132] = bflo(vc.y); d[3 * 132] = bfhi(vc.y); d[4 * 132] = bflo(vc.z); d[5 * 132] = bfhi(vc.z); d[6 * 132] = bflo(vc.w); d[7 * 132] = bfhi(vc.w); } }
            __syncthreads();
#pragma unroll 4
            for (int k = 0; k < 32; ++k) {
                const f32x4 a0 = *(const f32x4*)(As + k * 132 + ty * 8), a1 = *(const f32x4*)(As + k * 132 + ty * 8 + 4);
                const f32x4 bv = *(const f32x4*)(Bs + k * 132 + tx * 4);
                const float av[8] = {a0.x, a0.y, a0.z, a0.w, a1.x, a1.y, a1.z, a1.w};
#pragma unroll
                for (int i = 0; i < 8; ++i) { acc[i][0] += av[i] * bv.x; acc[i][1] += av[i] * bv.y; acc[i][2] += av[i] * bv.z; acc[i][3] += av[i] * bv.w; }
                if (MODE == 1) { const f32x4 cv = *(const f32x4*)(Bs2 + k * 132 + tx * 4);
#pragma unroll
                    for (int i = 0; i < 8; ++i) { acc2[i][0] += av[i] * cv.x; acc2[i][1] += av[i] * cv.y; acc2[i][2] += av[i] * cv.z; acc2[i][3] += av[i] * cv.w; } }
            }
        }
#pragma unroll
        for (int i = 0; i < 8; ++i)
#pragma unroll
            for (int j = 0; j < 4; ++j) E(pm * 128 + ty * 8 + i, pn * 128 + tx * 4 + j, acc[i][j], acc2[i][j]);
    }
}
DEVI void ph_qknorm_naive(const P& p, int bid, int nb) {
    bf16_t* QKV = (bf16_t*)(p.ws + WS_ACT); const float* rope = (const float*)(p.ws + WS_ROPE);
    for (int idx = bid * NTHR + tid_opaque(); idx < T * 32; idx += nb * NTHR) {
        const int slot = idx & 31, t = idx >> 5, pos = t % SEQ;
        const int sec4 = slot >> 3, hs = slot & 7;
        const int sec = sec4 < 2 ? sec4 : sec4 + 1;
        bf16_t* v = QKV + (size_t)t * INW + sec * 512 + hs * 64;
        const bool isA = sec4 < 2, isq = (sec4 & 1) == 0;
        const float* g = (isA ? p.a_qk_norm : p.b_qk_norm) + (isq ? 0 : 64);
        float ss = 0.f;
        for (int i = 0; i < 64; ++i) { const float a = bf2f(v[i]); ss += a * a; }
        const float r = rsqrtf(ss * (1.f / 64.f) + EPS), qs = isq ? C2 : 1.f;
        for (int i = 0; i < 32; ++i) { float y1 = bf2f(v[i]) * r * g[i], y2 = bf2f(v[i + 32]) * r * g[i + 32];
            if (isA) { const float cs = rope[(pos * 32 + i) * 2], sn = rope[(pos * 32 + i) * 2 + 1]; const float o1 = y1 * cs - y2 * sn, o2 = y1 * sn + y2 * cs; y1 = o1; y2 = o2; }
            v[i] = (bf16_t)f2bf(y1 * qs); v[i + 32] = (bf16_t)f2bf(y2 * qs); }
    }
}
DEVI void ph_attnA_naive(const P& p, int bid, int nb) {
    const bf16_t* QKV = (const bf16_t*)(p.ws + WS_ACT); float* OA = (float*)(p.ws + WS_OA);
    const int tid = tid_opaque(), qi = tid & 127, quarter = tid >> 7;
    for (int unit = bid; unit < 4 * 4 * 2 * 64; unit += nb) {
        const int qc = unit & 63, mp = (unit >> 6) & 1, h = (unit >> 7) & 3, b = unit >> 9;
        const int row = b * SEQ + qc * 128 + qi;
        float q[64];
        { const u32x4* qp = (const u32x4*)(QKV + (size_t)row * INW + h * 128 + mp * 64);
#pragma unroll
          for (int i = 0; i < 8; ++i) { const u32x4 w = qp[i]; q[8 * i] = bflo(w.x); q[8 * i + 1] = bfhi(w.x); q[8 * i + 2] = bflo(w.y); q[8 * i + 3] = bfhi(w.y); q[8 * i + 4] = bflo(w.z); q[8 * i + 5] = bfhi(w.z); q[8 * i + 6] = bflo(w.w); q[8 * i + 7] = bfhi(w.w); } }
        const bf16_t* kb = QKV + (size_t)b * SEQ * INW + 512 + h * 128 + mp * 64;
        const bf16_t* vb = QKV + (size_t)b * SEQ * INW + 1024 + h * 128 + quarter * 32;
        float m = -INFINITY, l = 0.f, o[32];
#pragma unroll
        for (int i = 0; i < 32; ++i) o[i] = 0.f;
        for (int key = 0; key < SEQ; ++key) {
            const u32x4* kp = (const u32x4*)(kb + (size_t)key * INW);
            float s = 0.f;
#pragma unroll
            for (int i = 0; i < 8; ++i) { const u32x4 w = kp[i];
                s += q[8 * i] * bflo(w.x) + q[8 * i + 1] * bfhi(w.x) + q[8 * i + 2] * bflo(w.y) + q[8 * i + 3] * bfhi(w.y) + q[8 * i + 4] * bflo(w.z) + q[8 * i + 5] * bfhi(w.z) + q[8 * i + 6] * bflo(w.w) + q[8 * i + 7] * bfhi(w.w); }
            const float mn = fmaxf(m, s), corr = exp2f(m - mn), pe = exp2f(s - mn); m = mn; l = l * corr + pe;
            const u32x4* vp = (const u32x4*)(vb + (size_t)key * INW);
#pragma unroll
            for (int i = 0; i < 4; ++i) { const u32x4 w = vp[i];
                o[8 * i] = o[8 * i] * corr + pe * bflo(w.x); o[8 * i + 1] = o[8 * i + 1] * corr + pe * bfhi(w.x); o[8 * i + 2] = o[8 * i + 2] * corr + pe * bflo(w.y); o[8 * i + 3] = o[8 * i + 3] * corr + pe * bfhi(w.y);
                o[8 * i + 4] = o[8 * i + 4] * corr + pe * bflo(w.z); o[8 * i + 5] = o[8 * i + 5] * corr + pe * bfhi(w.z); o[8 * i + 6] = o[8 * i + 6] * corr + pe * bflo(w.w); o[8 * i + 7] = o[8 * i + 7] * corr + pe * bfhi(w.w); }
        }
        const float il = 1.f / l;
        float* op = OA + ((size_t)mp * T + row) * 512 + h * 128 + quarter * 32;
#pragma unroll
        for (int i = 0; i < 32; ++i) op[i] = o[i] * il;
    }
}
DEVI float lam_value(const P& p, int lane) {
    const float* lp = p.a_lambda;
    const float s1 = wave_sum(lp[lane] * lp[64 + lane]), s2 = wave_sum(lp[128 + lane] * lp[192 + lane]);
    return __expf(s1) - __expf(s2) + 0.2f;
}
DEVI void ph_attnA_comb_naive(const P& p, int bid, int nb) {
    const float* OA = (const float*)(p.ws + WS_OA); bf16_t* H = (bf16_t*)(p.ws + WS_H);
    const int wave = tid_opaque() >> 6, lane = tid_opaque() & 63;
    const float lam = lam_value(p, lane);
    for (int it = bid * 8 + wave; it < T * 4; it += nb * 8) {
        const int h = it & 3, t = it >> 2;
        const float* o0 = OA + (size_t)t * 512 + h * 128; const float* o1 = OA + ((size_t)T + t) * 512 + h * 128;
        const float a = o0[lane] - lam * o1[lane], c = o0[lane + 64] - lam * o1[lane + 64];
        const float r = rsqrtf(wave_sum(a * a + c * c) * (1.f / 128.f) + EPS) * 0.8f;
        H[(size_t)t * DM + h * 128 + lane] = (bf16_t)f2bf(a * r * p.a_subln[lane]);
        H[(size_t)t * DM + h * 128 + 64 + lane] = (bf16_t)f2bf(c * r * p.a_subln[64 + lane]);
    }
}
DEVI void ph_natten_naive(const P& p, int bid, int nb) {
    const bf16_t* QKV = (const bf16_t*)(p.ws + WS_ACT); bf16_t* H = (bf16_t*)(p.ws + WS_H);
    for (int idx = bid * NTHR + tid_opaque(); idx < T * 16; idx += nb * NTHR) {
        const int half = idx & 1, h = (idx >> 1) & 7, t = idx >> 4, b = t / SEQ, s = t % SEQ, r = s >> 6, c = s & 63;
        const int rs = min(max(r - 4, 0), 120), cs = min(max(c - 8, 0), 48);
        float q[64], o[32];
        { const u32x4* qp = (const u32x4*)(QKV + (size_t)t * INW + 1536 + h * 64);
#pragma unroll
          for (int i = 0; i < 8; ++i) { const u32x4 w = qp[i]; q[8 * i] = bflo(w.x); q[8 * i + 1] = bfhi(w.x); q[8 * i + 2] = bflo(w.y); q[8 * i + 3] = bfhi(w.y); q[8 * i + 4] = bflo(w.z); q[8 * i + 5] = bfhi(w.z); q[8 * i + 6] = bflo(w.w); q[8 * i + 7] = bfhi(w.w); } }
#pragma unroll
        for (int i = 0; i < 32; ++i) o[i] = 0.f;
        float m = -INFINITY, l = 0.f;
        for (int kr = 0; kr < 8; ++kr)
            for (int kc = 0; kc < 16; ++kc) {
                const int krow = rs + kr, kcol = cs + kc; const size_t tk = (size_t)b * SEQ + krow * 64 + kcol;
                const u32x4* kp = (const u32x4*)(QKV + tk * INW + 2048 + h * 64);
                const u32x4* vp = (const u32x4*)(QKV + tk * INW + 2560 + h * 64 + half * 32);
                float sc = p.b_rpb[(h * 15 + (krow - r + 7)) * 31 + (kcol - c + 15)] * LOG2E;
#pragma unroll
                for (int i = 0; i < 8; ++i) { const u32x4 w = kp[i];
                    sc += q[8 * i] * bflo(w.x) + q[8 * i + 1] * bfhi(w.x) + q[8 * i + 2] * bflo(w.y) + q[8 * i + 3] * bfhi(w.y) + q[8 * i + 4] * bflo(w.z) + q[8 * i + 5] * bfhi(w.z) + q[8 * i + 6] * bflo(w.w) + q[8 * i + 7] * bfhi(w.w); }
                const float mn = fmaxf(m, sc), corr = exp2f(m - mn), pe = exp2f(sc - mn); m = mn; l = l * corr + pe;
#pragma unroll
                for (int i = 0; i < 4; ++i) { const u32x4 w = vp[i];
                    o[8 * i] = o[8 * i] * corr + pe * bflo(w.x); o[8 * i + 1] = o[8 * i + 1] * corr + pe * bfhi(w.x); o[8 * i + 2] = o[8 * i + 2] * corr + pe * bflo(w.y); o[8 * i + 3] = o[8 * i + 3] * corr + pe * bfhi(w.y);
                    o[8 * i + 4] = o[8 * i + 4] * corr + pe * bflo(w.z); o[8 * i + 5] = o[8 * i + 5] * corr + pe * bfhi(w.z); o[8 * i + 6] = o[8 * i + 6] * corr + pe * bflo(w.w); o[8 * i + 7] = o[8 * i + 7] * corr + pe * bfhi(w.w); }
            }
        const float il = 1.f / l;
        u32x4* op = (u32x4*)(H + (size_t)t * DM + 512 + h * 64 + half * 32);
#pragma unroll
        for (int i = 0; i < 4; ++i) { u32x4 w; w.x = pk2(o[8 * i] * il, o[8 * i + 1] * il); w.y = pk2(o[8 * i + 2] * il, o[8 * i + 3] * il); w.z = pk2(o[8 * i + 4] * il, o[8 * i + 5] * il); w.w = pk2(o[8 * i + 6] * il, o[8 * i + 7] * il); op[i] = w; }
    }
}

namespace pg8 {
#define PG8_LAS __attribute__((address_space(3)))
typedef unsigned short bf16_t;
typedef short bf16x8 __attribute__((ext_vector_type(8)));
typedef float f32x4 __attribute__((ext_vector_type(4)));
typedef unsigned u32x4 __attribute__((ext_vector_type(4)));
constexpr int BM = 256, BK = 64, HALF = 128, HTB = HALF * BK * 2  , STAGE_BYTES = 8 * HTB, NXCD = 8, WGM = 8;

__host__ __device__ __forceinline__ int lds_byte(int r, int c) { const int st = (r >> 4) * 2 + (c >> 5), rr = r & 15, cc = c & 31, ob = rr * 64 + cc * 2; return st * 1024 + (ob ^ (((ob >> 9) & 1) << 5)); }
__host__ __device__ __forceinline__ void stage_rc(int b, int& R, int& C) { const int st = b / 1024, sb = b % 1024, swz = sb ^ (((sb >> 9) & 1) << 5); R = (st >> 1) * 16 + swz / 64; C = (st & 1) * 32 + (swz % 64) / 2; }
__host__ __device__ __forceinline__ int perm32(int rho) { const int n = rho >> 4, i = rho & 15; return 8 * (i >> 2) + 4 * n + (i & 3); }

struct Unit { int pm, pn, par; };
struct Gemm { const bf16_t* A; const bf16_t* Bt; int M, N, K, lda, ldb, acol; };

struct StaticOrder {
    int nM, nN, nwg, G, c;
    __host__ __device__ void init(int M, int N, int G_, int c_) { nM = M / BM; nN = N / BM; nwg = nM * nN; G = G_; c = c_; }
    __host__ __device__ bool next(int i, Unit& u) const {
        const long L = (long)i * G + c; if (L >= nwg) return false;
        int wgid = (int)L; { const int q = nwg / NXCD, r = nwg % NXCD, xcd = wgid % NXCD, off = wgid / NXCD; wgid = (xcd < r ? xcd * (q + 1) : r * (q + 1) + (xcd - r) * q) + off; }
        const int nig = WGM * nN, gid = wgid / nig, fm = gid * WGM, gsz = (nM - fm) < WGM ? (nM - fm) : WGM;
        u.pm = fm + ((wgid % nig) % gsz); u.pn = (wgid % nig) / gsz; u.par = i & 1; return true;
    }
    __device__ __forceinline__ void a_ready(const Unit&) const {}
    __device__ __forceinline__ void done(const Unit&) const {}
};
__device__ __forceinline__ unsigned cvt_pk_bf16(float lo, float hi) { unsigned r; asm volatile("v_cvt_pk_bf16_f32 %0, %1, %2" : "=v"(r) : "v"(lo), "v"(hi)); return r; }
typedef float f32x2 __attribute__((ext_vector_type(2)));
template <class Epi, class Sched, bool ALIGN_EPI = false, bool SP2 = false>
__device__ __forceinline__ void gemm_phase(PG8_LAS unsigned char* lds, const Gemm g, const Sched S, const Epi E) {
    const int tid = tid_opaque(), wid = __builtin_amdgcn_readfirstlane(tid >> 6), lane = tid & 63, wr = wid >> 2, wc = wid & 3, fr = lane & 15, fq = lane >> 4;
    const int K = g.K, nt = K / BK;
    unsigned voffA[2], voffB[2];
#pragma unroll
    for (int i = 0; i < 2; ++i) { int R, C; stage_rc(tid * 16 + i * 8192, R, C); const int Rb = Epi::PERM ? ((R & ~31) + perm32(R & 31)) : R;
        voffA[i] = (unsigned)(R * g.lda + C) * 2u; voffB[i] = (unsigned)(Rb * g.ldb + C) * 2u; }
    const size_t kstep = (size_t)(BK * 2);
    const size_t hstepA = (size_t)HALF * g.lda * 2, hstepB = (size_t)HALF * g.ldb * 2;
    const size_t tstepA = 2 * hstepA, tstepB = 2 * hstepB, acolB = (size_t)g.acol * 2;
    const unsigned ldsw = (unsigned)wid * 1024u;
    const int aoff = lds_byte(wr * 64 + fr, fq * 8), boff = lds_byte(wc * 32 + fr, fq * 8);
#define PG8_SA(b, h) (((b) * 2 + (h)) * HTB)
#define PG8_SB(b, h) ((4 + (b) * 2 + (h)) * HTB)
#define PG8_STAGE(bufoff, gbase, voff) do { _Pragma("unroll") for (int _i = 0; _i < 2; ++_i) \
        __builtin_amdgcn_global_load_lds((const unsigned*)((const char*)(gbase) + (voff)[_i]), (PG8_LAS unsigned*)(lds + (bufoff) + ldsw + _i * 8192), 16, 0, 0); } while (0)
#define PG8_LDA(dst, b, h) do { _Pragma("unroll") for (int m = 0; m < 4; ++m) _Pragma("unroll") for (int k = 0; k < 2; ++k) dst[m][k] = *(const PG8_LAS bf16x8*)(lds + PG8_SA(b, h) + aoff + m * 2048 + k * 1024); } while (0)
#define PG8_LDB(dst, b, h) do { _Pragma("unroll") for (int n = 0; n < 2; ++n) _Pragma("unroll") for (int k = 0; k < 2; ++k) dst[n][k] = *(const PG8_LAS bf16x8*)(lds + PG8_SB(b, h) + boff + n * 2048 + k * 1024); } while (0)
#define PG8_MMA(ai, bj, At, Bt) do { __builtin_amdgcn_s_setprio(1); _Pragma("unroll") for (int m = 0; m < 4; ++m) _Pragma("unroll") for (int n = 0; n < 2; ++n) _Pragma("unroll") for (int k = 0; k < 2; ++k) \
        acc[ai][bj][m][n] = __builtin_amdgcn_mfma_f32_16x16x32_bf16(Bt[n][k], At[m][k], acc[ai][bj][m][n], 0, 0, 0); __builtin_amdgcn_s_setprio(0); } while (0)
#define PG8_WAIT_V(n) asm volatile("s_waitcnt vmcnt(" #n ")" ::: "memory")
#define PG8_WAIT_L(n) asm volatile("s_waitcnt lgkmcnt(" #n ")" ::: "memory")
#define PG8_BAR __builtin_amdgcn_s_barrier()
#define PG8_SCHED __builtin_amdgcn_sched_barrier(0)
    Unit cur, nxt; int ui = 0;
    if (!S.next(0, cur)) return;
    f32x4 acc[2][2][4][2];
#pragma unroll
    for (int a = 0; a < 2; ++a)
#pragma unroll
        for (int b = 0; b < 2; ++b)
#pragma unroll
            for (int m = 0; m < 4; ++m)
#pragma unroll
                for (int n = 0; n < 2; ++n) acc[a][b][m][n] = (f32x4){0.f, 0.f, 0.f, 0.f};
    bf16x8 At[4][2], B0[2][2], B1[2][2];
    const char* cA = (const char*)g.A + (size_t)cur.pm * tstepA + (size_t)cur.pn * acolB; const char* cB = (const char*)g.Bt + (size_t)cur.pn * tstepB;
    S.a_ready(cur);
    if constexpr (SP2) {
        PG8_STAGE(PG8_SB(0, 0), cB, voffB); PG8_STAGE(PG8_SB(0, 1), cB + hstepB, voffB); PG8_STAGE(PG8_SA(0, 0), cA, voffA); PG8_STAGE(PG8_SA(0, 1), cA + hstepA, voffA);
        if (wr == 1) PG8_BAR;
        PG8_WAIT_V(2); PG8_BAR;
        PG8_STAGE(PG8_SB(1, 0), cB + kstep, voffB); PG8_STAGE(PG8_SA(1, 0), cA + kstep, voffA); PG8_STAGE(PG8_SB(1, 1), cB + hstepB + kstep, voffB);
        PG8_WAIT_V(6); PG8_BAR;
    } else {
        PG8_STAGE(PG8_SB(0, 0), cB, voffB); PG8_STAGE(PG8_SA(0, 0), cA, voffA); PG8_STAGE(PG8_SB(0, 1), cB + hstepB, voffB); PG8_STAGE(PG8_SA(0, 1), cA + hstepA, voffA);
        if (wr == 1) PG8_BAR;
        PG8_WAIT_V(4); PG8_BAR;
        PG8_STAGE(PG8_SB(1, 0), cB + kstep, voffB); PG8_STAGE(PG8_SA(1, 0), cA + kstep, voffA); PG8_STAGE(PG8_SB(1, 1), cB + hstepB + kstep, voffB);
        PG8_WAIT_V(6); PG8_BAR;
    }
    for (;;) {
        const bool has_next = S.next(ui + 1, nxt);
        const char* nA = has_next ? (const char*)g.A + (size_t)nxt.pm * tstepA + (size_t)nxt.pn * acolB : cA; const char* nB = has_next ? (const char*)g.Bt + (size_t)nxt.pn * tstepB : cB;
        for (int t = 0; t < nt; t += 2) {
            const bool last = (t == nt - 2);
            const char* a1 = cA + (size_t)(t + 1) * kstep;
            const char* a2 = last ? nA : cA + (size_t)(t + 2) * kstep; const char* b2 = last ? nB : cB + (size_t)(t + 2) * kstep;
            const char* a3 = a2 + kstep; const char* b3 = b2 + kstep;
            if (last && has_next) S.a_ready(nxt);
            if constexpr (SP2) {
            PG8_LDB(B0, 0, 0); PG8_LDB(B1, 0, 1); PG8_SCHED; PG8_LDA(At, 0, 0); PG8_STAGE(PG8_SA(1, 1), a1 + hstepA, voffA);
            PG8_WAIT_V(8); PG8_WAIT_L(0); PG8_BAR; PG8_MMA(0, 0, At, B0); PG8_MMA(0, 1, At, B1); PG8_BAR; PG8_SCHED;
            PG8_LDA(At, 0, 1); PG8_STAGE(PG8_SB(0, 0), b2, voffB); PG8_STAGE(PG8_SB(0, 1), b2 + hstepB, voffB); PG8_STAGE(PG8_SA(0, 0), a2, voffA);
            PG8_WAIT_V(8); PG8_WAIT_L(0); PG8_BAR; PG8_MMA(1, 0, At, B0); PG8_MMA(1, 1, At, B1); PG8_BAR; PG8_SCHED;
            PG8_LDB(B0, 1, 0); PG8_LDB(B1, 1, 1); PG8_SCHED; PG8_LDA(At, 1, 0); PG8_STAGE(PG8_SA(0, 1), a2 + hstepA, voffA);
            PG8_WAIT_V(8); PG8_WAIT_L(0); PG8_BAR; PG8_MMA(0, 0, At, B0); PG8_MMA(0, 1, At, B1); PG8_BAR; PG8_SCHED;
            PG8_LDA(At, 1, 1); PG8_STAGE(PG8_SB(1, 0), b3, voffB); PG8_STAGE(PG8_SB(1, 1), b3 + hstepB, voffB); PG8_STAGE(PG8_SA(1, 0), a3, voffA);
            PG8_WAIT_V(8); PG8_WAIT_L(0); PG8_BAR; PG8_MMA(1, 0, At, B0); PG8_MMA(1, 1, At, B1); PG8_BAR; PG8_SCHED;
            } else {
            PG8_LDB(B0, 0, 0); PG8_SCHED; PG8_LDA(At, 0, 0); PG8_STAGE(PG8_SA(1, 1), a1 + hstepA, voffA);
            PG8_WAIT_L(8); PG8_BAR; PG8_WAIT_L(0); PG8_MMA(0, 0, At, B0); PG8_BAR; PG8_SCHED;
            PG8_LDB(B1, 0, 1); PG8_STAGE(PG8_SB(0, 0), b2, voffB);
            PG8_BAR; PG8_WAIT_L(0); PG8_MMA(0, 1, At, B1); PG8_BAR;
            PG8_LDA(At, 0, 1); PG8_STAGE(PG8_SA(0, 0), a2, voffA);
            PG8_BAR; PG8_WAIT_L(0); PG8_MMA(1, 0, At, B0); PG8_BAR; PG8_SCHED;
            PG8_STAGE(PG8_SB(0, 1), b2 + hstepB, voffB);
            PG8_WAIT_V(6); PG8_BAR; PG8_MMA(1, 1, At, B1); PG8_BAR;
            PG8_LDB(B0, 1, 0); PG8_SCHED; PG8_LDA(At, 1, 0); PG8_STAGE(PG8_SA(0, 1), a2 + hstepA, voffA);
            PG8_WAIT_L(8); PG8_BAR; PG8_WAIT_L(0); PG8_MMA(0, 0, At, B0); PG8_BAR; PG8_SCHED;
            PG8_LDB(B1, 1, 1); PG8_STAGE(PG8_SB(1, 0), b3, voffB);
            PG8_BAR; PG8_WAIT_L(0); PG8_MMA(0, 1, At, B1); PG8_BAR;
            PG8_LDA(At, 1, 1); PG8_STAGE(PG8_SA(1, 0), a3, voffA);
            PG8_BAR; PG8_WAIT_L(0); PG8_MMA(1, 0, At, B0); PG8_BAR; PG8_SCHED;
            PG8_STAGE(PG8_SB(1, 1), b3 + hstepB, voffB);
            PG8_WAIT_V(6); PG8_BAR; PG8_MMA(1, 1, At, B1); PG8_BAR;
            }
        }
        if constexpr (ALIGN_EPI) { if (wr == 0) PG8_BAR; }
        if constexpr (!Epi::AFTER_DRAIN) { E(acc, cur, wr, wc, fr, fq); S.done(cur); }
        if (!has_next) break;
#pragma unroll
        for (int a = 0; a < 2; ++a)
#pragma unroll
            for (int b = 0; b < 2; ++b)
#pragma unroll
                for (int m = 0; m < 4; ++m)
#pragma unroll
                    for (int n = 0; n < 2; ++n) acc[a][b][m][n] = (f32x4){0.f, 0.f, 0.f, 0.f};
        cur = nxt; cA = nA; cB = nB; ++ui;
        if constexpr (ALIGN_EPI) { if (wr == 1) PG8_BAR; }
    }
    PG8_WAIT_V(0);
    if constexpr (!ALIGN_EPI) { if (wr == 0) PG8_BAR; }
    PG8_BAR;
    if constexpr (Epi::AFTER_DRAIN) { E.fused(acc, cur, wr, wc, fr, fq, lds, wid, lane); S.done(cur); }
#undef PG8_SA
#undef PG8_SB
#undef PG8_STAGE
#undef PG8_LDA
#undef PG8_LDB
#undef PG8_MMA
#undef PG8_WAIT_V
#undef PG8_WAIT_L
#undef PG8_BAR
#undef PG8_SCHED
}
}

namespace pg8 {
DEVI float fast_silu(float a) { return a * __builtin_amdgcn_rcpf(1.f + __builtin_amdgcn_exp2f(-a * LOG2E)); }
DEVI u32x4 pack8(const f32x4 a, const f32x4 b) { u32x4 w; w.x = cvt_pk_bf16(a[0], a[1]); w.y = cvt_pk_bf16(a[2], a[3]); w.z = cvt_pk_bf16(b[0], b[1]); w.w = cvt_pk_bf16(b[2], b[3]); return w; }
struct EpiSwigluF { static constexpr bool PERM = true, AFTER_DRAIN = false; bf16_t* act; const PG8_LAS float* xl;
    DEVI void operator()(const f32x4 (&acc)[2][2][4][2], const Unit& u, int wr, int wc, int fr, int fq) const {
        const int row0 = u.pm * BM + wr * 64 + fr, col0 = u.pn * 128 + wc * 32 + 8 * fq;
        const PG8_LAS float* sl = xl + u.par * 512 + wr * 64 + fr; const PG8_LAS float* cp = xl + u.par * 512 + 256 + wc * 32 + 8 * fq;
        const f32x4 c00 = *(const PG8_LAS f32x4*)cp, c01 = *(const PG8_LAS f32x4*)(cp + 4), c10 = *(const PG8_LAS f32x4*)(cp + HALF), c11 = *(const PG8_LAS f32x4*)(cp + HALF + 4);
#pragma unroll
        for (int ai = 0; ai < 2; ++ai)
#pragma unroll
            for (int m = 0; m < 4; ++m) { const int row = row0 + ai * HALF + m * 16; bf16_t* rowp = act + (size_t)row * DFF + col0;
                const float r = rsqrtf(sl[ai * HALF + m * 16] * (1.f / DM) + EPS);
                const f32x4 a0 = acc[ai][0][m][0] * r + c00, a1 = acc[ai][0][m][1] * r + c01, b0 = acc[ai][1][m][0] * r + c10, b1 = acc[ai][1][m][1] * r + c11;
                f32x4 o0, o1;
#pragma unroll
                for (int i = 0; i < 4; ++i) { o0[i] = fast_silu(a0[i]) * b0[i]; o1[i] = fast_silu(a1[i]) * b1[i]; }
                *(u32x4*)rowp = pack8(o0, o1); }
    } };
struct EpiResidF { static constexpr bool PERM = false, AFTER_DRAIN = false;
    const float* xin; float* xout; const float* gate; const float* bias; const float* scale; int half;
    bf16_t* xt; const float* gn; const float* scn; float* ss;
    const bf16_t* xinb; bf16_t* xoutb;
    DEVI void operator()(const f32x4 (&acc)[2][2][4][2], const Unit& u, int wr, int wc, int fr, int fq) const {
        const int row0 = u.pm * BM + wr * 64 + fr, col0 = u.pn * BM + wc * 32 + 4 * fq, b = u.pm >> 5;
        const float* gp = gate + (size_t)b * 9 * 1024 + col0; const float coef = half ? 0.5f : 1.0f;
        float rs[2][4];
#pragma unroll
        for (int ai = 0; ai < 2; ++ai)
#pragma unroll
            for (int m = 0; m < 4; ++m) rs[ai][m] = 0.f;
#pragma unroll
        for (int bj = 0; bj < 2; ++bj) {
            u32x2 xw[2][2][4];
#pragma unroll
            for (int n = 0; n < 2; ++n) { const int co = bj * HALF + n * 16;
                if (bj == 1 ? (n == 0) : true) {
#pragma unroll
                    for (int nn = 0; nn < 2; ++nn) if (bj == 1 || nn == n) {
#pragma unroll
                        for (int ai = 0; ai < 2; ++ai)
#pragma unroll
                            for (int m = 0; m < 4; ++m) xw[nn][ai][m] = *(const u32x2*)(xinb + (size_t)(row0 + ai * HALF + m * 16) * DM + col0 + bj * HALF + nn * 16); } }
                f32x4 gv = *(const f32x4*)(gp + co) * coef, bv = {0.f, 0.f, 0.f, 0.f}, ggv = {0.f, 0.f, 0.f, 0.f};
                if (bias) { const f32x4 sv = *(const f32x4*)(scale + col0 + co); bv = *(const f32x4*)(bias + col0 + co) * sv * gv; gv = gv * sv; }
                if (xt) ggv = *(const f32x4*)(gn + col0 + co) * (*(const f32x4*)(scn + (size_t)b * 9 * 1024 + col0 + co) + 1.f);
#pragma unroll
                for (int ai = 0; ai < 2; ++ai)
#pragma unroll
                    for (int m = 0; m < 4; ++m) { const size_t off = (size_t)(row0 + ai * HALF + m * 16) * DM + col0 + co;
                        const u32x2 w0 = xw[n][ai][m];
                        const f32x4 xv = {__uint_as_float(w0.x << 16), __uint_as_float(w0.x & 0xffff0000u), __uint_as_float(w0.y << 16), __uint_as_float(w0.y & 0xffff0000u)};
                        const f32x4 xn = xv + bv + gv * acc[ai][bj][m][n];
                        if (xoutb) { u32x2 w; w.x = cvt_pk_bf16(xn[0], xn[1]); w.y = cvt_pk_bf16(xn[2], xn[3]); *(u32x2*)(xoutb + off) = w; }
                        else *(f32x4*)(xout + off) = xn;
                        if (xt) { rs[ai][m] += (xn[0] * xn[0] + xn[1] * xn[1]) + (xn[2] * xn[2] + xn[3] * xn[3]); const f32x4 y = xn * ggv;
                            u32x2 w; w.x = cvt_pk_bf16(y[0], y[1]); w.y = cvt_pk_bf16(y[2], y[3]); *(u32x2*)(xt + off) = w; } }
                if (bj == 0 || n == 1) asm volatile("" ::: "memory"); } }
        if (xt) {
#pragma unroll
            for (int ai = 0; ai < 2; ++ai)
#pragma unroll
                for (int m = 0; m < 4; ++m) { float t = rs[ai][m]; t += swz_xor<16>(t); t = add32(t);
                    if (fq == 0) unsafeAtomicAdd(ss + row0 + ai * HALF + m * 16, t); } }
    } };
struct EpiQKV { static constexpr bool PERM = true, AFTER_DRAIN = false; bf16_t* qkv; const float* rope; const float* a_qk; const float* b_qk; const PG8_LAS float* xl;
    DEVI void operator()(const f32x4 (&acc)[2][2][4][2], const Unit& u, int wr, int wc, int fr, int fq) const {
        const int sec = u.pn >> 1, row0 = u.pm * BM + wr * 64 + fr;
        const PG8_LAS float* sl = xl + u.par * 512 + wr * 64 + fr; const PG8_LAS float* cp = xl + u.par * 512 + 256 + wc * 32 + 8 * fq;
        if (sec == 2 || sec == 5) {
            const f32x4 cv[2][2] = {{*(const PG8_LAS f32x4*)cp, *(const PG8_LAS f32x4*)(cp + 4)}, {*(const PG8_LAS f32x4*)(cp + HALF), *(const PG8_LAS f32x4*)(cp + HALF + 4)}};
            const int col0 = u.pn * BM + wc * 32 + 8 * fq;
#pragma unroll
            for (int ai = 0; ai < 2; ++ai)
#pragma unroll
                for (int m = 0; m < 4; ++m) { const int row = row0 + ai * HALF + m * 16; bf16_t* rowp = qkv + (size_t)row * INW + col0;
                    const float r = rsqrtf(sl[ai * HALF + m * 16] * (1.f / DM) + EPS);
#pragma unroll
                    for (int bj = 0; bj < 2; ++bj) *(u32x4*)(rowp + bj * HALF) = pack8(acc[ai][bj][m][0] * r + cv[bj][0], acc[ai][bj][m][1] * r + cv[bj][1]); }
        } else {
            const bool isA = sec < 2, isq = (sec == 0 || sec == 3);
            const float* g = (isA ? a_qk : b_qk) + (isq ? 0 : 64) + 8 * fq;
            const f32x4 g1[2] = {*(const f32x4*)g, *(const f32x4*)(g + 4)}, g2[2] = {*(const f32x4*)(g + 32), *(const f32x4*)(g + 36)};
            const float qs = isq ? C2 : 1.f;
#pragma unroll
            for (int ai = 0; ai < 2; ++ai)
#pragma unroll
                for (int m = 0; m < 4; ++m) { const int row = row0 + ai * HALF + m * 16;
                    const float rr = rsqrtf(sl[ai * HALF + m * 16] * (1.f / DM) + EPS);
                    const f32x4 cv[2][2] = {{*(const PG8_LAS f32x4*)cp, *(const PG8_LAS f32x4*)(cp + 4)}, {*(const PG8_LAS f32x4*)(cp + HALF), *(const PG8_LAS f32x4*)(cp + HALF + 4)}};
                    f32x4 y1[2], y2[2]; float sq = 0.f;
#pragma unroll
                    for (int n = 0; n < 2; ++n) { y1[n] = acc[ai][0][m][n] * rr + cv[0][n]; y2[n] = acc[ai][1][m][n] * rr + cv[1][n];
                        sq += (y1[n][0] * y1[n][0] + y1[n][1] * y1[n][1]) + (y1[n][2] * y1[n][2] + y1[n][3] * y1[n][3]) + (y2[n][0] * y2[n][0] + y2[n][1] * y2[n][1]) + (y2[n][2] * y2[n][2] + y2[n][3] * y2[n][3]); }
                    sq += swz_xor<16>(sq); sq = add32(sq);
                    const float r = rsqrtf(sq * (1.f / 64.f) + EPS);
#pragma unroll
                    for (int n = 0; n < 2; ++n) { y1[n] = y1[n] * r * g1[n]; y2[n] = y2[n] * r * g2[n]; }
                    if (isA) { const f32x4* rp = (const f32x4*)(rope + ((size_t)(row & (SEQ - 1)) * 32 + 8 * fq) * 2);
                        const f32x4 t0 = rp[0], t1 = rp[1], t2 = rp[2], t3 = rp[3];
                        const float cs[8] = {t0[0], t0[2], t1[0], t1[2], t2[0], t2[2], t3[0], t3[2]}, sn[8] = {t0[1], t0[3], t1[1], t1[3], t2[1], t2[3], t3[1], t3[3]};
#pragma unroll
                        for (int n = 0; n < 2; ++n)
#pragma unroll
                            for (int i = 0; i < 4; ++i) { const float a = y1[n][i], b2 = y2[n][i]; y1[n][i] = a * cs[4 * n + i] - b2 * sn[4 * n + i]; y2[n][i] = a * sn[4 * n + i] + b2 * cs[4 * n + i]; } }
#pragma unroll
                    for (int n = 0; n < 2; ++n) { y1[n] = y1[n] * qs; y2[n] = y2[n] * qs; }
                    bf16_t* dst = qkv + (size_t)row * INW + u.pn * BM + wc * 64 + 8 * fq;
                    *(u32x4*)dst = pack8(y1[0], y1[1]); *(u32x4*)(dst + 32) = pack8(y2[0], y2[1]); asm volatile("" ::: "memory"); }
        }
    } };
}


namespace att {
#define ALAS __attribute__((address_space(3)))
typedef short bf16x8 __attribute__((ext_vector_type(8)));
typedef short s16x4 __attribute__((ext_vector_type(4)));
typedef short v4i16_t __attribute__((ext_vector_type(4)));
typedef float f32x16 __attribute__((ext_vector_type(16)));
constexpr int SLOT = 16384, VOFF = 3 * SLOT, NT = SEQ / 64;
DEVI int crow(int r, int hi) { return (r & 3) + 8 * (r >> 2) + 4 * hi; }
DEVI s16x4 vtr(const ALAS unsigned char* p) { return __builtin_bit_cast(s16x4, __builtin_amdgcn_ds_read_tr16_b64_v4i16((ALAS v4i16_t*)p)); }
typedef float f32x2_t __attribute__((ext_vector_type(2))); typedef __bf16 bf16x2_t __attribute__((ext_vector_type(2)));
DEVI unsigned cvtpk(float lo, float hi) { f32x2_t v = {lo, hi}; bf16x2_t b = __builtin_convertvector(v, bf16x2_t); return __builtin_bit_cast(unsigned, b); }
DEVI void glds16(const void* g, unsigned lds_dst) {
    unsigned keep; asm volatile("s_mov_b32 %0, m0\n\ts_mov_b32 m0, %2\n\ts_nop 0\n\tglobal_load_lds_dwordx4 %1, off\n\ts_mov_b32 m0, %0" : "=&s"(keep) : "v"(g), "s"(lds_dst) : "memory"); }

template <bool SH> DEVI void attnA_body(const P& p, bf16_t* H, ALAS unsigned char* lds, int bid, int nb, const float shf) {
    const int tid = tid_opaque(), lane = tid & 63, r32 = lane & 31, hi = lane >> 5;
    const int wid = __builtin_amdgcn_readfirstlane(tid >> 6), qsub = wid >> 1, mp = wid & 1;
    const bf16_t* QKV = (const bf16_t*)(p.ws + WS_ACT);
    const float lam = lam_value(p, lane);
    const int vlane = ((lane >> 4) & 1) * 32 + (lane & 3) * 8 + (4 * hi + ((lane & 15) >> 2)) * 64;
    const int ksw = (r32 >> 2) & 3, kbase = (r32 >> 4) * 4096 + mp * 2048 + (r32 & 15) * 64, kx0 = ((hi) ^ ksw) * 16, kx1 = ((2 + hi) ^ ksw) * 16;
    const unsigned lds0 = (unsigned)(uintptr_t)lds;
    for (int i = 0;; ++i) {
        const int u = i * nb + bid; if (u >= 1024) break;
        int bh, qblk;
        if (nb == 256) { bh = (bid & 7) * 2 + (i >> 1); qblk = (i & 1) * 32 + (bid >> 3); } else { bh = u >> 6; qblk = u & 63; }
        const int b = bh >> 2, h = bh & 3; const size_t rowbase = (size_t)b * SEQ; const int q0 = qblk * 128;
        bf16x8 qr[4];
        { const bf16_t* Qw = QKV + (rowbase + q0 + qsub * 32 + r32) * INW + h * 128 + mp * 64 + hi * 8;
#pragma unroll
          for (int d0 = 0; d0 < 4; ++d0) qr[d0] = *(const bf16x8*)(Qw + d0 * 16); }
        asm volatile("s_waitcnt vmcnt(0)" : "+v"(qr[0]), "+v"(qr[1]), "+v"(qr[2]), "+v"(qr[3]) :: "memory");
        const bf16_t* ksrc = QKV + (rowbase + (wid & 3) * 16 + (lane >> 2)) * INW + 512 + h * 128 + (wid >> 2) * 64 + (((lane & 3) ^ ((lane >> 4) & 3)) * 8);
        const bf16_t* vsrc = QKV + (rowbase + 16 * (wid & 3) + (lane >> 2)) * INW + 1024 + h * 128 + (wid >> 2) * 64 + (lane & 3) * 8;
        const unsigned kdst = __builtin_amdgcn_readfirstlane(lds0 + ((wid & 3) * 4 + (wid >> 2) * 2) * 1024), vdst = __builtin_amdgcn_readfirstlane(lds0 + VOFF + ((wid >> 2) * 8 + (wid & 3)) * 1024);
#define ATT_ISSUE_K(t, so) do { const size_t go_ = (size_t)(t) * 64 * INW; glds16(ksrc + go_, kdst + (so)); glds16(ksrc + go_ + 32, kdst + (so) + 1024); } while (0)
#define ATT_ISSUE_V(t, so) do { const size_t go_ = (size_t)(t) * 64 * INW; glds16(vsrc + go_, vdst + (so)); glds16(vsrc + go_ + 32, vdst + (so) + 4096); } while (0)
#define ATT_WAITBAR(n) asm volatile("s_waitcnt vmcnt(" #n ") lgkmcnt(0)\n\ts_barrier" ::: "memory")
#define ATT_SB() __builtin_amdgcn_sched_barrier(0)
#define ATT_KLOAD(so) do { const ALAS unsigned char* Ks = lds + (so) + kbase; \
        _Pragma("unroll") for (int d0 = 0; d0 < 4; ++d0) { const int xo_ = (d0 >> 1) * 1024 + ((d0 & 1) ? kx1 : kx0); kf[2 * d0] = *(const ALAS bf16x8*)(Ks + xo_); kf[2 * d0 + 1] = *(const ALAS bf16x8*)(Ks + xo_ + 8192); } } while (0)
#define ATT_QKM() do { \
        _Pragma("unroll") for (int r = 0; r < 16; ++r) { p0[r] = 0.f; p1[r] = 0.f; } \
        _Pragma("unroll") for (int d0 = 0; d0 < 4; ++d0) { \
            p0 = __builtin_amdgcn_mfma_f32_32x32x16_bf16(kf[2 * d0], qr[d0], p0, 0, 0, 0); p1 = __builtin_amdgcn_mfma_f32_32x32x16_bf16(kf[2 * d0 + 1], qr[d0], p1, 0, 0, 0); } } while (0)
#define ATT_VLOAD(buf, so, cb) do { const ALAS unsigned char* Vs = lds + VOFF + (so) + vlane + (cb) * 4096; \
        _Pragma("unroll") for (int ks = 0; ks < 4; ++ks) { buf[2 * ks] = vtr(Vs + ks * 1024); buf[2 * ks + 1] = vtr(Vs + ks * 1024 + 512); } } while (0)
#define ATT_PVG(PW, buf, cb) do { _Pragma("unroll") for (int ks = 0; ks < 4; ++ks) { \
        const bf16x8 vf = (bf16x8){buf[2 * ks][0], buf[2 * ks][1], buf[2 * ks][2], buf[2 * ks][3], buf[2 * ks + 1][0], buf[2 * ks + 1][1], buf[2 * ks + 1][2], buf[2 * ks + 1][3]}; \
        o[cb] = __builtin_amdgcn_mfma_f32_32x32x16_bf16(__builtin_bit_cast(bf16x8, PW[ks]), vf, o[cb], 0, 0, 0); } } while (0)
#define ATT_EXPG(PN, P, B, k) do { float e_[8]; _Pragma("unroll") for (int r = 0; r < 8; ++r) { e_[r] = __builtin_amdgcn_exp2f(SH ? P[(B) + r] - shf : P[(B) + r]); } \
        _Pragma("unroll") for (int r = 0; r < 8; ++r) lsum += e_[r];     \
        PN[k] = (u32x4){cvtpk(e_[0], e_[1]), cvtpk(e_[2], e_[3]), cvtpk(e_[4], e_[5]), cvtpk(e_[6], e_[7])}; } while (0)
#define ATT_STEP(PO, PN, sknext, sv, ldk) do { ATT_QKM(); ATT_VLOAD(va, sv, 0); ATT_SB(); \
        ATT_VLOAD(vb, sv, 1); ATT_PVG(PO, va, 0); ATT_EXPG(PN, p0, 0, 0); ATT_SB(); \
        ATT_VLOAD(va, sv, 2); ATT_PVG(PO, vb, 1); ATT_EXPG(PN, p0, 8, 1); ATT_SB(); \
        ATT_VLOAD(vb, sv, 3); ATT_PVG(PO, va, 2); ATT_EXPG(PN, p1, 0, 2); ATT_SB(); \
        if (ldk) ATT_KLOAD(sknext); \
        ATT_PVG(PO, vb, 3); ATT_EXPG(PN, p1, 8, 3); ATT_SB(); } while (0)
#define ATT_ROT() do { const int tmp_ = s0; s0 = s1; s1 = s2; s2 = tmp_; } while (0)
        ATT_ISSUE_K(0, 0); ATT_ISSUE_K(1, SLOT); ATT_ISSUE_V(0, 0); ATT_ISSUE_K(2, 2 * SLOT);
        f32x16 o[4], p0, p1; u32x4 pwa[4], pwb[4]; s16x4 va[8], vb[8]; bf16x8 kf[8];
#pragma unroll
        for (int cb = 0; cb < 4; ++cb)
#pragma unroll
            for (int r = 0; r < 16; ++r) o[cb][r] = 0.f;
        float lsum = 0.f;
        ATT_WAITBAR(6); ATT_KLOAD(0);
        ATT_WAITBAR(4); ATT_ISSUE_K(3, 0); ATT_ISSUE_V(1, SLOT);
        ATT_QKM(); ATT_KLOAD(SLOT); ATT_EXPG(pwa, p0, 0, 0); ATT_EXPG(pwa, p0, 8, 1); ATT_EXPG(pwa, p1, 0, 2); ATT_EXPG(pwa, p1, 8, 3);
        int s0 = SLOT, s1 = 2 * SLOT, s2 = 0;
        for (int t = 1; t < NT - 4; t += 2) {
            ATT_WAITBAR(4); ATT_ISSUE_K(t + 3, s0); ATT_ISSUE_V(t + 1, s1);
            ATT_STEP(pwa, pwb, s1, s2, true); ATT_ROT();
            ATT_WAITBAR(4); ATT_ISSUE_K(t + 4, s0); ATT_ISSUE_V(t + 2, s1);
            ATT_STEP(pwb, pwa, s1, s2, true); ATT_ROT();
        }
        ATT_WAITBAR(4); ATT_ISSUE_V(NT - 2, s1);
        ATT_STEP(pwa, pwb, s1, s2, true); ATT_ROT();
        ATT_WAITBAR(2); ATT_ISSUE_V(NT - 1, s1);
        ATT_STEP(pwb, pwa, s1, s2, true); ATT_ROT();
        ATT_WAITBAR(2);
        ATT_STEP(pwa, pwb, s1, s2, false);
        ATT_WAITBAR(0);
        ATT_VLOAD(va, s0, 0); ATT_VLOAD(vb, s0, 1); ATT_PVG(pwb, va, 0); ATT_PVG(pwb, vb, 1); ATT_VLOAD(va, s0, 2); ATT_VLOAD(vb, s0, 3); ATT_PVG(pwb, va, 2); ATT_PVG(pwb, vb, 3);
#undef ATT_ROT
#undef ATT_ISSUE_K
#undef ATT_ISSUE_V
#undef ATT_WAITBAR
#undef ATT_SB
#undef ATT_KLOAD
#undef ATT_QKM
#undef ATT_VLOAD
#undef ATT_PVG
#undef ATT_EXPG
#undef ATT_STEP
        lsum = add32(lsum);
        float linv = 1.f / lsum; if (mp == 1) linv *= lam;
#pragma unroll
        for (int r = 0; r < 16; ++r) { const float sc = __shfl(linv, crow(r, hi));
#pragma unroll
            for (int cb = 0; cb < 4; ++cb) o[cb][r] *= sc; }
        asm volatile("s_waitcnt lgkmcnt(0)\n\ts_barrier" ::: "memory");
        ALAS float* xb = (ALAS float*)lds + qsub * 4096;
        if (mp == 1) {
#pragma unroll
            for (int r = 0; r < 16; ++r)
#pragma unroll
                for (int cb = 0; cb < 4; ++cb) xb[crow(r, hi) * 128 + cb * 32 + r32] = o[cb][r];
        }
        asm volatile("s_waitcnt lgkmcnt(0)\n\ts_barrier" ::: "memory");
        if (mp == 0) {
            float gsub[4];
#pragma unroll
            for (int cb = 0; cb < 4; ++cb) gsub[cb] = p.a_subln[cb * 32 + r32] * 0.8f;
#pragma unroll
            for (int r = 0; r < 16; ++r) { float ss = 0.f;
#pragma unroll
                for (int cb = 0; cb < 4; ++cb) { o[cb][r] -= xb[crow(r, hi) * 128 + cb * 32 + r32]; ss += o[cb][r] * o[cb][r]; }
                ss += swz_xor<1>(ss); ss += swz_xor<2>(ss); ss += swz_xor<4>(ss); ss += swz_xor<8>(ss); ss += swz_xor<16>(ss);
                const float rn = rsqrtf(ss * (1.f / 128.f) + EPS);
                bf16_t* orow = H + (rowbase + q0 + qsub * 32 + crow(r, hi)) * DM + h * 128 + r32;
#pragma unroll
                for (int cb = 0; cb < 4; ++cb) orow[cb * 32] = (bf16_t)f2bf(o[cb][r] * rn * gsub[cb]); }
        }
        asm volatile("s_waitcnt lgkmcnt(0)\n\ts_barrier" ::: "memory");
    }
}
DEVI void ph_attnA(const P& p, bf16_t* H, ALAS unsigned char* lds, int bid, int nb) {
    const int lane = tid_opaque() & 63;
    float gq = fabsf(p.a_qk_norm[lane]), gk = fabsf(p.a_qk_norm[64 + lane]);
    gq = wave_max(gq); gk = wave_max(gk);
    const float shf = __uint_as_float(__builtin_amdgcn_readfirstlane(__float_as_uint(fmaxf(8.f * LOG2E * gq * gk - 64.f, 0.f))));
    if (shf != 0.f) attnA_body<true>(p, H, lds, bid, nb, shf); else attnA_body<false>(p, H, lds, bid, nb, 0.f);
}
}


#ifndef DBG
#define DBG 1
#endif
DEVI void ph_dbg_cmp(const P& p, int bid, int nb) {
    const bf16_t* H = (const bf16_t*)(p.ws + WS_H); const bf16_t* H2 = (const bf16_t*)(p.ws + WS_OA); const bf16_t* H3 = H2 + (size_t)T * DM;
    float d0 = 0.f, d1 = 0.f;
    for (size_t i = (size_t)bid * NTHR + tid_opaque(); i < (size_t)T * 512; i += (size_t)nb * NTHR) { const size_t t = i >> 9, c = i & 511, o = t * DM + c;
        const float a = bf2f(H[o]), b = bf2f(H2[o]), c3 = bf2f(H3[o]); float e0 = fabsf(a - b), e1 = fabsf(b - c3);
        if (!(e0 == e0)) e0 = 1e6f; if (!(e1 == e1)) e1 = 1e6f;
        d0 = fmaxf(d0, e0); d1 = fmaxf(d1, e1); }
    d0 = wave_max(d0); d1 = wave_max(d1);
    if ((tid_opaque() & 63) == 0) { unsigned* w = (unsigned*)(p.ws + WS_DBGW); atomicMax(w, __float_as_uint(d0)); atomicMax(w + 1, __float_as_uint(d1)); }
}


namespace pg8 {
struct PrefetchOrder : StaticOrder {
    const float* ss; const float* cb; int cbstride; unsigned ldsx;
    DEVI void a_ready(const Unit& u) const {
        const int tid_ = tid_opaque(), wid = __builtin_amdgcn_readfirstlane(tid_ >> 6), lane = tid_ & 63;
        if (wid == 0) att::glds16(ss + (size_t)u.pm * BM + lane * 4, ldsx + u.par * 2048);
        else if (wid == 1) att::glds16(cb + (size_t)(u.pm >> 5) * cbstride + u.pn * BM + lane * 4, ldsx + u.par * 2048 + 1024);
    }
};
}

namespace nat {
using att::bf16x8; using att::s16x4; using att::vtr; using att::cvtpk; using att::glds16;
typedef float f32x4v __attribute__((ext_vector_type(4)));
constexpr int XOFF = 65536;
DEVI void ph_natten(const P& p, ALAS unsigned char* lds, int bid, int nb) {
    const int tid = tid_opaque(), lane = tid & 63, t16 = lane & 15, g = lane >> 4;
    const int wid = __builtin_amdgcn_readfirstlane(tid >> 6), j = wid & 3, hh = wid >> 2;
    const bf16_t* QKV = (const bf16_t*)(p.ws + WS_ACT); bf16_t* H = (bf16_t*)(p.ws + WS_H);
    const unsigned lds0 = (unsigned)(uintptr_t)lds;
    const int c0 = (j == 0) ? 0 : (j == 1) ? 8 : (j == 2) ? 24 : 32;
    const int qc = 16 * j + t16, cs = min(max(qc - 8, 0), 48);
    const int nunits = NBATCH * 8 * 128, per = (nunits + nb - 1) / nb;
    int cur_bh = -1, cur_rs = -100;
    for (int i = 0; i < per; ++i) {
        const int u = bid * per + i; if (u >= nunits) break;
        const int bh = u >> 7, r = u & 127, b = bh >> 3, h = bh & 7, rs = min(max(r - 4, 0), 120);
        const size_t rowbase = (size_t)b * SEQ;
        { const bf16_t* vrow0 = QKV + (rowbase + (lane >> 3)) * INW + 2560 + h * 64 + (lane & 7) * 8;
          if (bh != cur_bh || rs != cur_rs + 1) {
              if (bh != cur_bh || rs != cur_rs) {
                  const int krow = rs + wid; const unsigned vdst = __builtin_amdgcn_readfirstlane(lds0 + (krow & 7) * 8192);
#pragma unroll
                  for (int pc = 0; pc < 8; ++pc) glds16(vrow0 + (size_t)(krow * 64 + pc * 8) * INW, vdst + pc * 1024); }
          } else { const int krow = rs + 7; glds16(vrow0 + (size_t)(krow * 64 + wid * 8) * INW, __builtin_amdgcn_readfirstlane(lds0 + (krow & 7) * 8192 + wid * 1024)); }
          cur_bh = bh; cur_rs = rs; }
        bf16x8 qf[2];
        { const bf16_t* qp = QKV + (rowbase + (size_t)r * 64 + qc) * INW + 1536 + h * 64 + 8 * g; qf[0] = *(const bf16x8*)qp; qf[1] = *(const bf16x8*)(qp + 32); }
        f32x4v s[8];
        const bf16_t* kbase = QKV + (rowbase + (size_t)(rs + 4 * hh) * 64 + c0 + t16) * INW + 2048 + h * 64 + 8 * g;
#pragma unroll
        for (int tl = 0; tl < 8; ++tl) { const bf16_t* kp = kbase + (size_t)((tl >> 1) * 64 + (tl & 1) * 16) * INW;
            const bf16x8 k0 = *(const bf16x8*)kp, k1 = *(const bf16x8*)(kp + 32);
            f32x4v a = {0.f, 0.f, 0.f, 0.f};
            a = __builtin_amdgcn_mfma_f32_16x16x32_bf16(k0, qf[0], a, 0, 0, 0); a = __builtin_amdgcn_mfma_f32_16x16x32_bf16(k1, qf[1], a, 0, 0, 0); s[tl] = a; }
        float lsum = 0.f; unsigned pw[4][4];
#pragma unroll
        for (int kr = 0; kr < 4; ++kr) { const int krow = rs + 4 * hh + kr; const float* bp = p.b_rpb + (h * 15 + (krow - r + 7)) * 31;
            float e[8];
#pragma unroll
            for (int ct = 0; ct < 2; ++ct)
#pragma unroll
                for (int rg = 0; rg < 4; ++rg) { const int kc = c0 + 16 * ct + 4 * g + rg; const bool ok = (kc >= cs) && (kc < cs + 16);
                    const float bias = bp[min(max(kc - qc + 15, 0), 30)]; const float v = __builtin_amdgcn_exp2f(s[kr * 2 + ct][rg] + bias * LOG2E);
                    e[ct * 4 + rg] = ok ? v : 0.f; lsum += e[ct * 4 + rg]; }
#pragma unroll
            for (int k2 = 0; k2 < 4; ++k2) pw[kr][k2] = cvtpk(e[2 * k2], e[2 * k2 + 1]); }
        lsum += swz_xor<16>(lsum); lsum = add32(lsum);
        asm volatile("s_waitcnt vmcnt(0)\n\ts_barrier" ::: "memory");
        f32x4v o[4];
#pragma unroll
        for (int dt = 0; dt < 4; ++dt) o[dt] = (f32x4v){0.f, 0.f, 0.f, 0.f};
        const ALAS unsigned char* vb = lds + (size_t)(c0 + 4 * g + (t16 >> 2)) * 128 + (t16 & 3) * 8;
#pragma unroll
        for (int kr = 0; kr < 4; ++kr) { const u32x4 pa = {pw[kr][0], pw[kr][1], pw[kr][2], pw[kr][3]}; const int ro = ((rs + 4 * hh + kr) & 7) * 8192;
#pragma unroll
            for (int dt = 0; dt < 4; ++dt) { const s16x4 lo = vtr(vb + ro + dt * 32), hv = vtr(vb + ro + 2048 + dt * 32);
                const bf16x8 vf = (bf16x8){lo[0], lo[1], lo[2], lo[3], hv[0], hv[1], hv[2], hv[3]};
                o[dt] = __builtin_amdgcn_mfma_f32_16x16x32_bf16(__builtin_bit_cast(bf16x8, pa), vf, o[dt], 0, 0, 0); } }
        ALAS float* xo = (ALAS float*)(lds + XOFF) + j * 1040;
        if (hh == 1) {
#pragma unroll
            for (int dt = 0; dt < 4; ++dt)
#pragma unroll
                for (int rg = 0; rg < 4; ++rg) xo[(4 * g + rg) * 64 + dt * 16 + t16] = o[dt][rg];
            if (lane < 16) xo[1024 + lane] = lsum;
        }
        asm volatile("s_waitcnt lgkmcnt(0)\n\ts_barrier" ::: "memory");
        if (hh == 0) {
            const float lt = lsum + xo[1024 + t16];
            const float li = 1.f / lt;
            bf16_t* orow = H + (rowbase + (size_t)r * 64 + 16 * j) * DM + 512 + h * 64 + t16;
#pragma unroll
            for (int rg = 0; rg < 4; ++rg) { const float sc = __shfl(li, 4 * g + rg);
#pragma unroll
                for (int dt = 0; dt < 4; ++dt) orow[(size_t)(4 * g + rg) * DM + dt * 16] = (bf16_t)f2bf((o[dt][rg] + xo[(4 * g + rg) * 64 + dt * 16 + t16]) * sc); }
        }
        asm volatile("s_waitcnt lgkmcnt(0)\n\ts_barrier" ::: "memory");
    }
}
}


#define LAS __attribute__((address_space(3)))
#define XB_TMO      128
#define XB_XCNT(j)  (256  + 64 * (j))
#define XB_XSUB(j)  (1280 + 64 * (j))
#define XB_XGEN(j)  (2304 + 64 * (j))
#define XB_TOP      3328
#define XB_TOPGEN   3392
#define XCD_BAR_WORDS 3456
#define XB_SPIN_CAP (1u << 18)

__device__ __forceinline__ unsigned xb_ld(unsigned* p)              { return __hip_atomic_load(p, __ATOMIC_RELAXED, __HIP_MEMORY_SCOPE_AGENT); }
__device__ __forceinline__ unsigned xb_add(unsigned* p, unsigned v) { return __hip_atomic_fetch_add(p, v, __ATOMIC_RELAXED, __HIP_MEMORY_SCOPE_AGENT); }
__device__ __forceinline__ unsigned xb_xcc_id() { return (unsigned)__builtin_amdgcn_s_getreg((3 << 11) | 20) & 0xFu; }
#define XB_SPIN(cond, bar) do { unsigned _sp = 0; while (cond) { \
    if ((++_sp & 255u) == 0u) { if (xb_ld(&(bar)[XB_TMO])) break; if (_sp > XB_SPIN_CAP) { atomicAdd(&(bar)[XB_TMO], 1u); break; } } } } while (0)

struct XcdBarrier {
    unsigned* bar; unsigned x;
    volatile LAS unsigned* st;
};

__device__ __forceinline__ XcdBarrier xcd_barrier_post(unsigned* bar, volatile LAS unsigned* st) {
    XcdBarrier b; b.bar = bar; b.x = xb_xcc_id(); b.st = st;
    if (threadIdx.x == 0) (void)xb_add(&bar[XB_XCNT(b.x)], 1u);
    return b;
}
__device__ __forceinline__ void xcd_barrier_complete(unsigned* bar, unsigned x, unsigned& nloc, unsigned& nx) {
    const unsigned G = gridDim.x * gridDim.y * gridDim.z;
    unsigned sum, cnt, mine, sp = 0u;
    for (;;) {
        sum = 0u; cnt = 0u; mine = 0u;
#pragma unroll
        for (unsigned j = 0; j < 16; ++j) { const unsigned c = xb_ld(&bar[XB_XCNT(j)]); sum += c; cnt += (c > 0u) ? 1u : 0u; mine = (j == x) ? c : mine; }
        if (sum == G) break;
        __builtin_amdgcn_s_sleep(1);
        if ((++sp & 255u) == 0u) { if (xb_ld(&bar[XB_TMO])) break; if (sp > XB_SPIN_CAP) { atomicAdd(&bar[XB_TMO], 1u); break; } }
    }
    nloc = mine > 0u ? mine : 1u; nx = cnt > 0u ? cnt : 1u;
}

__device__ __forceinline__ void xcd_barrier(const XcdBarrier& b) {
    asm volatile("s_waitcnt vmcnt(0)" ::: "memory");
    __syncthreads();
    if (threadIdx.x == 0) {
        unsigned* bar = b.bar;
        __builtin_amdgcn_s_waitcnt(0);
        unsigned nloc = b.st[0], nx = b.st[1];
        if (nloc == 0u) { xcd_barrier_complete(bar, b.x, nloc, nx); b.st[0] = nloc; b.st[1] = nx; }
        const unsigned old = xb_add(&bar[XB_XSUB(b.x)], 1u);
        const unsigned gen = old / nloc;
        if (old + 1u == (gen + 1u) * nloc) {
            __builtin_amdgcn_fence(__ATOMIC_RELEASE, "agent");
            asm volatile("s_waitcnt vmcnt(0)" ::: "memory");
            const unsigned og = xb_add(&bar[XB_TOP], 1u);
            const unsigned tg = og / nx;
            if (og + 1u == (tg + 1u) * nx) xb_add(&bar[XB_TOPGEN], 1u);
            else XB_SPIN(xb_ld(&bar[XB_TOPGEN]) == tg, bar);
            __builtin_amdgcn_fence(__ATOMIC_ACQUIRE, "agent");
            xb_add(&bar[XB_XGEN(b.x)], 1u);
            asm volatile("s_waitcnt vmcnt(0)" ::: "memory");
        } else {
            XB_SPIN(xb_ld(&bar[XB_XGEN(b.x)]) == gen, bar);
            __builtin_amdgcn_fence(__ATOMIC_ACQUIRE, "agent");
            asm volatile("s_waitcnt vmcnt(0)" ::: "memory");
        }
    }
    __syncthreads();
}

enum Kind { K_MODP, K_PRO, K_NORM, K_UP, K_DOWN, K_IN, K_QKN, K_ATTA, K_ATTC, K_NAT, K_OUT, K_POOL, K_PGEMM, K_DBGA, K_DBGC, K_DBGO, K_NORM0 };
struct Ph { unsigned char kind, layer, f; };
#ifndef FAST_GEMM
#define FAST_GEMM 1
#endif
#ifndef FAST_ATTA
#define FAST_ATTA 1
#endif
#ifndef FAST_NAT
#define FAST_NAT 1
#endif
#if DBG
#define NPH 28
#define MIXPH {K_QKN, 0, 0}, {K_ATTA, 0, 0}, {K_ATTC, 0, 0}, {K_DBGA, 0, 0}, {K_DBGA, 0, 1}, {K_DBGC, 0, 0}, {K_NAT, 0, 0},
#elif FAST_GEMM && FAST_ATTA && FAST_NAT
#define NPH 16
#define FUSED_NORM 1
#else
#define NPH 23
#define MIXPH {K_QKN, 0, 0}, {K_ATTA, 0, 0}, {K_ATTC, 0, 0}, {K_NAT, 0, 0},
#endif
#ifndef FUSED_NORM
#define FUSED_NORM 0
#endif
__device__ __constant__ const Ph g_prog[NPH] = {
#if FUSED_NORM
    {K_MODP, 0, 0}, {K_PRO, 0, 0},
    {K_NORM0, 0, 0}, {K_UP, 0, 0}, {K_DOWN, 0, 0},
    {K_IN, 0, 0}, {K_ATTA, 0, 0}, {K_OUT, 0, 0},
    {K_UP, 0, 1}, {K_DOWN, 0, 1},
    {K_UP, 1, 0}, {K_DOWN, 1, 0},
    {K_POOL, 1, 0}, {K_PGEMM, 1, 0},
    {K_UP, 1, 1}, {K_DOWN, 1, 1}
#else
    {K_MODP, 0, 0}, {K_PRO, 0, 0},
    {K_NORM, 0, 0}, {K_UP, 0, 0}, {K_DOWN, 0, 0},
    {K_NORM, 0, 1}, {K_IN, 0, 0}, MIXPH {K_OUT, 0, 0},
    {K_NORM, 0, 2}, {K_UP, 0, 1}, {K_DOWN, 0, 1},
    {K_NORM, 1, 0}, {K_UP, 1, 0}, {K_DOWN, 1, 0},
    {K_POOL, 1, 0}, {K_PGEMM, 1, 0},
    {K_NORM, 1, 2}, {K_UP, 1, 1}, {K_DOWN, 1, 1}
#if DBG
    , {K_DBGO, 0, 0}, {K_DBGO, 0, 1}
#endif
#endif
};

#ifndef ENMASK
#define ENMASK 0xffffu
#endif
template <class Epi> DEVI void fast_gemm(const bf16_t* A, int lda, const bf16_t* Bt, int ldb, int M, int N, int K, int acol, const Epi E, float* lds, int bid, int nb) {
    pg8::Gemm g{A, Bt, M, N, K, lda, ldb, acol}; pg8::StaticOrder S; S.init(M, N, nb, bid);
    pg8::gemm_phase<Epi, pg8::StaticOrder, true, true>((PG8_LAS unsigned char*)lds, g, S, E);
}
template <class Epi> DEVI void fast_gemm_pf(const bf16_t* A, const bf16_t* Bt, int N, const float* ss, const float* cb, const Epi E, float* lds, int bid, int nb) {
    pg8::Gemm g{A, Bt, T, N, DM, DM, DM, 0}; pg8::PrefetchOrder S; S.init(T, N, nb, bid); S.ss = ss; S.cb = cb; S.cbstride = N; S.ldsx = (unsigned)(uintptr_t)((PG8_LAS unsigned char*)lds) + pg8::STAGE_BYTES;
    pg8::gemm_phase<Epi, pg8::PrefetchOrder, true, true>((PG8_LAS unsigned char*)lds, g, S, E);
}
DEVI void run_phase(const P& p, int kind, int layer, int f, float* lds, int bid, int nb) {
    const bool first = (layer == 0 && f == 0);
    bf16_t* H = (bf16_t*)(p.ws + WS_H); bf16_t* ACT = (bf16_t*)(p.ws + WS_ACT);
    const float* mod = (const float*)(p.ws + WS_MOD);
    switch (kind) {
    case K_MODP: if constexpr ((ENMASK >> K_MODP) & 1) { ph_modp(p, lds, bid, nb); } break;
    case K_PRO: if constexpr ((ENMASK >> K_PRO) & 1) { ph_modfinal(p, bid, nb); ph_rope(p, bid, nb); ph_weights(p, lds, bid, nb); } break;
    case K_NORM: if constexpr ((ENMASK >> K_NORM) & 1) { ph_norm(p, first ? p.x : p.out, layer, f, bid, nb); } break;
#if FAST_GEMM
    case K_NORM0: ph_norm0(p, bid, nb); break;
    case K_UP: if constexpr ((ENMASK >> K_UP) & 1) { const int lf = layer * 2 + f;
        pg8::EpiSwigluF E; E.act = ACT; E.xl = (const PG8_LAS float*)((PG8_LAS unsigned char*)lds + pg8::STAGE_BYTES);
        fast_gemm_pf((lf & 1) ? (const bf16_t*)(p.ws + WS_H2) : H, (const bf16_t*)(p.ws + WS_W13T) + (size_t)lf * W13T_ELEMS, 2 * DFF,
                     (const float*)(p.ws + WS_SS) + (size_t)(lf == 0 ? 0 : lf + 1) * T, (const float*)(p.ws + WS_CB) + (size_t)lf * 4 * 2 * DFF, E, lds, bid, nb); } break;
    case K_DOWN: case K_OUT: case K_PGEMM: if constexpr ((ENMASK >> K_DOWN) & 1) {
        const bool dn = kind == K_DOWN, pl = kind == K_PGEMM;
        const bool lastp = dn && layer == 1 && f == 1;
        pg8::EpiResidF E; E.xin = p.x; E.xout = p.out; E.xinb = (const bf16_t*)(p.ws + WS_XB); E.xoutb = lastp ? nullptr : (bf16_t*)(p.ws + WS_XB); E.gate = mod + (size_t)(layer * 4 * 9 + (dn ? (f == 0 ? 2 : 8) : 5)) * 1024;
        E.half = dn ? 1 : 0; E.bias = pl ? p.pool_b : nullptr; E.scale = pl ? p.pool_scale : nullptr;
        const bool has = !(dn && layer == 1);
        const int nl = dn ? (f == 0 ? 0 : 1) : layer, nsub = dn ? (f == 0 ? 1 : 0) : 2, ssid = dn ? (f == 0 ? 1 : 3) : (pl ? 4 : 2);
        E.xt = has ? (dn ? H : (bf16_t*)(p.ws + WS_H2)) : nullptr; E.gn = p.norm_g + (nl * 3 + nsub) * 1024; E.scn = mod + (size_t)(nl * 4 * 9 + nsub * 3 + 1) * 1024; E.ss = (float*)(p.ws + WS_SS) + (size_t)ssid * T;
        const bf16_t* Bt = dn ? (const bf16_t*)(p.ws + WS_W2T) + (size_t)(layer * 2 + f) * W2T_ELEMS : pl ? (const bf16_t*)(p.ws + WS_POOLT) : (const bf16_t*)(p.ws + WS_WOUTT);
        const int K = dn ? DFF : pl ? 256 : DM;
        fast_gemm(dn ? ACT : H, dn ? DFF : DM, Bt, K, T, DM, K, pl ? 256 : 0, E, lds, bid, nb); } break;
    case K_IN: if constexpr ((ENMASK >> K_IN) & 1) { pg8::EpiQKV E; E.qkv = ACT; E.rope = (const float*)(p.ws + WS_ROPE); E.a_qk = p.a_qk_norm; E.b_qk = p.b_qk_norm;
        E.xl = (const PG8_LAS float*)((PG8_LAS unsigned char*)lds + pg8::STAGE_BYTES);
        fast_gemm_pf(H, (const bf16_t*)(p.ws + WS_WINT), INW, (const float*)(p.ws + WS_SS) + (size_t)1 * T, (const float*)(p.ws + WS_CB) + (size_t)16 * 2 * DFF, E, lds, bid, nb); } break;
    case K_QKN: break;
#else
    case K_UP: if constexpr ((ENMASK >> K_UP) & 1) { { EpiSwiglu E{ACT}; ph_gemm_naive<1>(H, DM, (const bf16_t*)(p.ws + WS_W13T) + (size_t)(layer * 2 + f) * W13T_ELEMS, DM, T, DFF, DM, E, lds, bid, nb); } } break;
    case K_DOWN: if constexpr ((ENMASK >> K_DOWN) & 1) { { EpiResid E{first ? p.x : p.out, p.out, mod, 0.5f, nullptr, nullptr, layer, f == 0 ? 2 : 8};
        ph_gemm_naive<0>(ACT, DFF, (const bf16_t*)(p.ws + WS_W2T) + (size_t)(layer * 2 + f) * W2T_ELEMS, DFF, T, DM, DFF, E, lds, bid, nb); } } break;
    case K_IN: if constexpr ((ENMASK >> K_IN) & 1) { { EpiRawQKV E{ACT}; ph_gemm_naive<0>(H, DM, (const bf16_t*)(p.ws + WS_WINT), DM, T, INW, DM, E, lds, bid, nb); } } break;
    case K_QKN: if constexpr ((ENMASK >> K_QKN) & 1) { ph_qknorm_naive(p, bid, nb); } break;
    case K_OUT: if constexpr ((ENMASK >> K_OUT) & 1) { { EpiResid E{p.out, p.out, mod, 1.0f, nullptr, nullptr, layer, 5}; ph_gemm_naive<0>(H, DM, (const bf16_t*)(p.ws + WS_WOUTT), DM, T, DM, DM, E, lds, bid, nb); } } break;
    case K_PGEMM: if constexpr ((ENMASK >> K_PGEMM) & 1) { { EpiResid E{p.out, p.out, mod, 1.0f, p.pool_b, p.pool_scale, layer, 5}; ph_gemm_naive<2>(H, DM, (const bf16_t*)(p.ws + WS_POOLT), 256, T, DM, 256, E, lds, bid, nb); } } break;
#endif
#if DBG
    case K_DBGA: att::ph_attnA(p, (bf16_t*)(p.ws + WS_OA) + (size_t)f * T * DM, (ALAS unsigned char*)lds, bid, nb); break;
    case K_DBGC: ph_dbg_cmp(p, bid, nb); break;
    case K_DBGO: if (bid == 0 && tid_opaque() == 0 && f == 0) { const float* w = (const float*)(p.ws + WS_DBGW); p.out[0] += 1000.f * w[0] + 1e6f * w[1]; } break;
#endif
#if FAST_ATTA && !DBG
    case K_ATTA: if constexpr ((ENMASK >> K_ATTA) & 1) { att::ph_attnA(p, (bf16_t*)(p.ws + WS_H), (ALAS unsigned char*)lds, bid, nb);
#if FAST_GEMM && FAST_NAT
        nat::ph_natten(p, (ALAS unsigned char*)lds, bid, nb);
#endif
        } break;
    case K_ATTC: break;
#else
    case K_ATTA: if constexpr ((ENMASK >> K_ATTA) & 1) { ph_attnA_naive(p, bid, nb); } break;
    case K_ATTC: if constexpr ((ENMASK >> K_ATTC) & 1) { ph_attnA_comb_naive(p, bid, nb); } break;
#endif
#if FAST_NAT
    case K_NAT: if constexpr ((ENMASK >> K_NAT) & 1) { nat::ph_natten(p, (ALAS unsigned char*)lds, bid, nb); } break;
#else
    case K_NAT: if constexpr ((ENMASK >> K_NAT) & 1) { ph_natten_naive(p, bid, nb); } break;
#endif
    case K_POOL: if constexpr ((ENMASK >> K_POOL) & 1) { ph_pool(p, p.out, lds, bid, nb); } break;
    default: break;
    }
}

constexpr int LDS_USED = 135168, LDS_BYTES = LDS_USED + 64;

#if !MEGA
__global__ void __launch_bounds__(NTHR) k_one(P p, int ph) {
    extern __shared__ __attribute__((aligned(16))) float lds[];
    const Ph e = g_prog[ph];
    run_phase(p, e.kind, e.layer, e.f, lds, blockIdx.x, gridDim.x);
}
#define K_MAIN k_one
#else
__global__ void __launch_bounds__(NTHR) k_mega(P p) {
    extern __shared__ __attribute__((aligned(16))) float lds[];
    cg::grid_group grid = cg::this_grid();
    volatile LAS unsigned* st = (volatile LAS unsigned*)((LAS unsigned char*)lds + LDS_USED);
    if (threadIdx.x < 2) st[threadIdx.x] = 0u;
    __syncthreads();
    { const Ph e = g_prog[0]; run_phase(p, e.kind, e.layer, e.f, lds, blockIdx.x, gridDim.x); }
    if (blockIdx.x == 0) { unsigned* bw = (unsigned*)(p.ws + WS_BAR); for (int i = threadIdx.x; i < XCD_BAR_WORDS; i += NTHR) bw[i] = 0u; }
    grid.sync();
    const XcdBarrier bar = xcd_barrier_post((unsigned*)(p.ws + WS_BAR), st);
    for (int ph = 1; ph < NPH; ++ph) {
        const Ph e = g_prog[ph];
        run_phase(p, e.kind, e.layer, e.f, lds, blockIdx.x, gridDim.x);
        if (ph + 1 < NPH) xcd_barrier(bar);
    }
}
#define K_MAIN k_mega
#endif

extern "C" void kernel_launch(void* const* d_in, const int* in_sizes, int n_in, void* d_out, int out_size, void* d_ws, size_t ws_size, hipStream_t stream) {
    static int grid = 0;
    if (grid == 0) {
        if (n_in != 17 || in_sizes[0] != T * DM || out_size != T * DM || ws_size < WS_END) { fprintf(stderr, "kernel_launch: unexpected shapes/ws (n_in %d, ws %zu)\n", n_in, ws_size); grid = -1; return; }
        int dev = 0, cus = 0, per_cu = 0;
        (void)hipGetDevice(&dev); (void)hipDeviceGetAttribute(&cus, hipDeviceAttributeMultiprocessorCount, dev);
        (void)hipFuncSetAttribute((const void*)K_MAIN, hipFuncAttributeMaxDynamicSharedMemorySize, LDS_BYTES);
        (void)hipOccupancyMaxActiveBlocksPerMultiprocessor(&per_cu, (const void*)K_MAIN, NTHR, LDS_BYTES);
        if (per_cu < 1) per_cu = 1;
        if (per_cu > 1) per_cu = 1;
        grid = cus * per_cu;
        (void)hipGetLastError();
    }
    if (grid < 0) return;
    P p{};
    const float** pp = (const float**)&p;
    for (int i = 0; i < 17; ++i) pp[i] = (const float*)d_in[i];
    p.out = (float*)d_out; p.ws = (unsigned char*)d_ws;
#if MEGA
    void* args[] = {&p};
    hipError_t e = hipLaunchCooperativeKernel((const void*)k_mega, dim3(grid), dim3(NTHR), args, LDS_BYTES, stream);
    if (e != hipSuccess) fprintf(stderr, "cooperative launch failed: %s (grid %d)\n", hipGetErrorString(e), grid);
#else
    for (int ph = 0; ph < NPH; ++ph) hipLaunchKernelGGL(k_one, dim3(grid * 4), dim3(NTHR), LDS_BYTES, stream, p, ph);
#endif
}
```

```cpp
#include <hip/hip_runtime.h>
#include <hip/hip_cooperative_groups.h>
#include <cstdio>
#include <cstdint>
namespace cg = cooperative_groups;

#ifndef DBG
#define DBG 0
#endif
#ifndef MEGA
#define MEGA 1
#endif

#define DEVI __device__ __forceinline__
typedef unsigned short bf16_t;
typedef float f32x4 __attribute__((ext_vector_type(4)));
typedef unsigned u32x4 __attribute__((ext_vector_type(4)));
typedef unsigned u32x2 __attribute__((ext_vector_type(2)));

constexpr int DM = 1024, NBATCH = 4, SEQ = 8192, T = NBATCH * SEQ, DFF = 2816, INW = 3072;
constexpr float EPS = 1e-6f, LOG2E = 1.4426950408889634f, C2 = 0.125f * LOG2E;
constexpr int NTHR = 512;

constexpr size_t MiB = 1u << 20;
constexpr size_t WS_MODP = 0, WS_MOD = 3 * MiB, WS_ROPE = 4 * MiB, WS_W13T = 6 * MiB, WS_W2T = 50 * MiB, WS_WINT = 72 * MiB, WS_WOUTT = 78 * MiB,
                 WS_POOLT = 80 * MiB, WS_H = 82 * MiB, WS_ACT = 146 * MiB, WS_OA = 338 * MiB, WS_END = 466 * MiB;
constexpr size_t WS_SS = 2359296, WS_CB = WS_MOD + 589824, WS_H2 = WS_OA;
constexpr size_t WS_XB = WS_OA + 64 * MiB;
constexpr size_t WS_BAR = 81 * MiB;
constexpr size_t WS_DBGW = WS_MOD + 512 * 1024;
constexpr size_t W13T_ELEMS = (size_t)2 * DFF * DM, W2T_ELEMS = (size_t)DM * DFF;

struct P {
    const float *x, *c, *ada_w, *ada_b, *norm_g, *ff_w13, *ff_w2, *w_in, *w_out, *a_qk_norm, *a_lambda, *a_subln, *b_qk_norm, *b_rpb, *pool_w, *pool_b, *pool_scale;
    float* out; unsigned char* ws;
};

DEVI int tid_opaque() { int t = threadIdx.x; asm volatile("" : "+v"(t)); return t; }
DEVI float bf2f(unsigned v) { return __uint_as_float(v << 16); }
DEVI float bflo(unsigned w) { return __uint_as_float(w << 16); }
DEVI float bfhi(unsigned w) { return __uint_as_float(w & 0xffff0000u); }
DEVI unsigned f2bf(float f) { unsigned u = __float_as_uint(f); return (u + 0x7fffu + ((u >> 16) & 1u)) >> 16; }
DEVI unsigned pk2(float lo, float hi) { return f2bf(lo) | (f2bf(hi) << 16); }
template <int M> DEVI float swz_xor(float v) { static_assert(M > 0 && M < 32, "ds_swizzle bit mode works inside 32-lane halves"); return __int_as_float(__builtin_amdgcn_ds_swizzle(__float_as_int(v), 0x1f | (M << 10))); }
DEVI float add32(float v) { const auto rr = __builtin_amdgcn_permlane32_swap(__float_as_uint(v), __float_as_uint(v), false, false); return __uint_as_float(rr[0]) + __uint_as_float(rr[1]); }
DEVI float max32(float v) { const auto rr = __builtin_amdgcn_permlane32_swap(__float_as_uint(v), __float_as_uint(v), false, false); return fmaxf(__uint_as_float(rr[0]), __uint_as_float(rr[1])); }
DEVI float wave_sum(float v) { v += swz_xor<1>(v); v += swz_xor<2>(v); v += swz_xor<4>(v); v += swz_xor<8>(v); v += swz_xor<16>(v); return add32(v); }
DEVI float wave_max(float v) { v = fmaxf(v, swz_xor<1>(v)); v = fmaxf(v, swz_xor<2>(v)); v = fmaxf(v, swz_xor<4>(v)); v = fmaxf(v, swz_xor<8>(v)); v = fmaxf(v, swz_xor<16>(v)); return max32(v); }
DEVI float siluf(float a) { return a / (1.f + __expf(-a)); }
DEVI const float* modptr(const P& p, int layer, int b, int m) { return (const float*)(p.ws + WS_MOD) + ((size_t)(layer * 4 + b) * 9 + m) * 1024; }

constexpr int MODP_KC = 7, MODP_KLEN = 147;
DEVI void ph_modp(const P& p, float* lds, int bid, int nb) {
    float* modp = (float*)(p.ws + WS_MODP);
#if DBG
    if (bid == 0 && tid_opaque() < 2) ((unsigned*)(p.ws + WS_DBGW))[tid_opaque()] = 0u;
#endif
    for (int i = tid_opaque(); i < 4096; i += NTHR) lds[i] = siluf(p.c[i]);
    { f32x4* ssz = (f32x4*)(p.ws + WS_SS) + T / 4; for (int i = bid * NTHR + tid_opaque(); i < 4 * T / 4; i += nb * NTHR) ssz[i] = (f32x4){0.f, 0.f, 0.f, 0.f}; }
    __syncthreads();
    const int total = 2 * MODP_KC * 9216;
    for (int i = bid * NTHR + tid_opaque(); i < total; i += nb * NTHR) {
        const int j = i % 9216, lk = i / 9216, l = lk / MODP_KC, kc = lk % MODP_KC;
        const int kb = kc * MODP_KLEN, ke = min(kb + MODP_KLEN, 1024);
        const float* w = p.ada_w + ((size_t)l * 1024 + kb) * 9216 + j;
        float a0 = 0.f, a1 = 0.f, a2 = 0.f, a3 = 0.f;
#pragma unroll 16
        for (int k = kb; k < ke; ++k) { const float wv = w[(size_t)(k - kb) * 9216];
            a0 += lds[k] * wv; a1 += lds[1024 + k] * wv; a2 += lds[2048 + k] * wv; a3 += lds[3072 + k] * wv; }
        float* o = modp + ((size_t)(kc * 2 + l) * 4) * 9216 + j;
        o[0] = a0; o[9216] = a1; o[2 * 9216] = a2; o[3 * 9216] = a3;
    }
}
DEVI void ph_modfinal(const P& p, int bid, int nb) {
    const float* modp = (const float*)(p.ws + WS_MODP); float* mod = (float*)(p.ws + WS_MOD);
    const int total = 2 * 4 * 9216;
    for (int i = bid * NTHR + tid_opaque(); i < total; i += nb * NTHR) {
        const int j = i % 9216, lb = i / 9216, l = lb >> 2, b = lb & 3;
        float s = p.ada_b[l * 9216 + j];
#pragma unroll
        for (int kc = 0; kc < MODP_KC; ++kc) s += modp[((size_t)(kc * 2 + l) * 4 + b) * 9216 + j];
        mod[i] = s;
    }
}
DEVI void ph_rope(const P& p, int bid, int nb) {
    float* rope = (float*)(p.ws + WS_ROPE);
    for (int i = bid * NTHR + tid_opaque(); i < SEQ * 32; i += nb * NTHR) {
        const int pos = i >> 5, f = i & 31;
        const float inv = powf(10000.f, -(float)(2 * f) / 64.f);
        const float ang = (float)pos * inv;
        rope[2 * i] = cosf(ang); rope[2 * i + 1] = sinf(ang);
    }
}
DEVI int map_id(int n) { return n; }
DEVI int map_w13(int n) { const int half = n >= DFF, nn = half ? n - DFF : n; return (nn >> 7) * 256 + half * 128 + (nn & 127); }
DEVI int map_win(int n) {
    const int sec = n >> 9; if (sec == 2 || sec == 5) return n;
    const int tile = n >> 8, w = n & 255, head = w >> 6, dim = w & 63; return tile * 256 + (dim >> 5) * 128 + head * 32 + (dim & 31);
}
template <int MAP> DEVI void transpose_item(const float* W, int K, int N, bf16_t* WT, float* scr, int item, int lane) {
    const int nblk = N / 32, kb = item / nblk, nbk = item % nblk, k0 = 64 * kb, n0 = 32 * nbk;
    float wv[32];
#pragma unroll
    for (int i = 0; i < 32; ++i) wv[i] = W[(size_t)(k0 + 2 * i + (lane >> 5)) * N + n0 + (lane & 31)];
#pragma unroll
    for (int i = 0; i < 32; ++i) scr[(2 * i + (lane >> 5)) * 33 + (lane & 31)] = wv[i];
    asm volatile("s_waitcnt lgkmcnt(0)" ::: "memory");
    const int c = lane & 7;
#pragma unroll
    for (int j = 0; j < 4; ++j) { const int n = (lane >> 3) + 8 * j; const float* s = scr + (8 * c) * 33 + n;
        u32x4 o; o.x = pk2(s[0 * 33], s[1 * 33]); o.y = pk2(s[2 * 33], s[3 * 33]); o.z = pk2(s[4 * 33], s[5 * 33]); o.w = pk2(s[6 * 33], s[7 * 33]);
        const int nn = n0 + n; const int row = MAP == 0 ? map_id(nn) : MAP == 1 ? map_w13(nn) : map_win(nn);
        *(u32x4*)(WT + (size_t)row * K + k0 + 8 * c) = o; }
    asm volatile("s_waitcnt lgkmcnt(0)" ::: "memory");
}
DEVI void ph_weights(const P& p, float* lds, int bid, int nb) {
    const int wave = tid_opaque() >> 6, lane = tid_opaque() & 63;
    float* scr = lds + wave * (64 * 33);
    const int gw = bid * 8 + wave, NGW = nb * 8;
    constexpr int I13 = (DM / 64) * (2 * DFF / 32), I2 = (DFF / 64) * (DM / 32), IIN = (DM / 64) * (INW / 32), IOUT = (DM / 64) * (DM / 32), IPL = (256 / 64) * (256 / 32);
    constexpr int NITEMS = 4 * I13 + 4 * I2 + IIN + IOUT + 4 * IPL;
    bf16_t* W13T = (bf16_t*)(p.ws + WS_W13T); bf16_t* W2T = (bf16_t*)(p.ws + WS_W2T);
    for (int it = gw; it < NITEMS; it += NGW) {
        int r = it;
        if (r < 4 * I13) { const int m = r / I13; transpose_item<1>(p.ff_w13 + (size_t)m * DM * 2 * DFF, DM, 2 * DFF, W13T + (size_t)m * W13T_ELEMS, scr, r % I13, lane); continue; } r -= 4 * I13;
        if (r < 4 * I2) { const int m = r / I2; transpose_item<0>(p.ff_w2 + (size_t)m * DFF * DM, DFF, DM, W2T + (size_t)m * W2T_ELEMS, scr, r % I2, lane); continue; } r -= 4 * I2;
        if (r < IIN) { transpose_item<2>(p.w_in, DM, INW, (bf16_t*)(p.ws + WS_WINT), scr, r, lane); continue; } r -= IIN;
        if (r < IOUT) { transpose_item<0>(p.w_out, DM, DM, (bf16_t*)(p.ws + WS_WOUTT), scr, r, lane); continue; } r -= IOUT;
        { const int g = r / IPL; transpose_item<0>(p.pool_w + (size_t)g * 65536, 256, 256, (bf16_t*)(p.ws + WS_POOLT) + (size_t)g * 65536, scr, r % IPL, lane); }
    }
}
DEVI void ph_norm(const P& p, const float* xin, int layer, int sub, int bid, int nb) {
    bf16_t* H = (bf16_t*)(p.ws + WS_H);
    const float* g = p.norm_g + (layer * 3 + sub) * 1024;
    const int wave = tid_opaque() >> 6, lane = tid_opaque() & 63;
    for (int row = bid * 8 + wave; row < T; row += nb * 8) {
        const int b = row / SEQ;
        const float* sh = modptr(p, layer, b, sub * 3 + 0); const float* sc = modptr(p, layer, b, sub * 3 + 1);
        const f32x4* xr = (const f32x4*)(xin + (size_t)row * DM) + lane;
        f32x4 v[4]; float ss = 0.f;
#pragma unroll
        for (int j = 0; j < 4; ++j) { v[j] = xr[64 * j]; ss += (v[j].x * v[j].x + v[j].y * v[j].y) + (v[j].z * v[j].z + v[j].w * v[j].w); }
        const float r = rsqrtf(wave_sum(ss) * (1.f / DM) + EPS);
        u32x2* o8 = (u32x2*)(H + (size_t)row * DM) + lane;
#pragma unroll
        for (int j = 0; j < 4; ++j) { const int c = 4 * lane + 256 * j;
            const f32x4 gv = *(const f32x4*)(g + c), sv = *(const f32x4*)(sc + c), hv = *(const f32x4*)(sh + c);
            const f32x4 y = (v[j] * r) * gv * (sv + 1.f) + hv;
            u32x2 w; w.x = pk2(y.x, y.y); w.y = pk2(y.z, y.w); o8[64 * j] = w; }
    }
}
DEVI void ph_norm0(const P& p, int bid, int nb) {
    bf16_t* H = (bf16_t*)(p.ws + WS_H); float* SS = (float*)(p.ws + WS_SS);
    const float* g = p.norm_g;
    const int wave = tid_opaque() >> 6, lane = tid_opaque() & 63;
    for (int row = bid * 8 + wave; row < T; row += nb * 8) {
        const int b = row / SEQ; const float* sc = modptr(p, 0, b, 1);
        const f32x4* xr = (const f32x4*)(p.x + (size_t)row * DM) + lane;
        f32x4 v[4]; float ss = 0.f;
#pragma unroll
        for (int j = 0; j < 4; ++j) { v[j] = xr[64 * j]; ss += (v[j].x * v[j].x + v[j].y * v[j].y) + (v[j].z * v[j].z + v[j].w * v[j].w); }
        ss = wave_sum(ss); if (lane == 0) SS[row] = ss;
        u32x2* o8 = (u32x2*)(H + (size_t)row * DM) + lane; u32x2* x8 = (u32x2*)((bf16_t*)(p.ws + WS_XB) + (size_t)row * DM) + lane;
#pragma unroll
        for (int j = 0; j < 4; ++j) { const int c = 4 * lane + 256 * j;
            const f32x4 y = v[j] * *(const f32x4*)(g + c) * (*(const f32x4*)(sc + c) + 1.f);
            u32x2 w; w.x = pk2(y.x, y.y); w.y = pk2(y.z, y.w); o8[64 * j] = w;
            u32x2 xw; xw.x = pk2(v[j].x, v[j].y); xw.y = pk2(v[j].z, v[j].w); x8[64 * j] = xw; }
    }
    float* CB = (float*)(p.ws + WS_CB);
    const int nrows = 4 * 2 * DFF + INW;
    for (int rw = bid * 8 + wave; rw < nrows; rw += nb * 8) {
        const bf16_t* wt; int layer, m, n, ostride; float* out;
        if (rw < 4 * 2 * DFF) { const int lf = rw / (2 * DFF); n = rw % (2 * DFF); wt = (const bf16_t*)(p.ws + WS_W13T) + (size_t)lf * W13T_ELEMS + (size_t)n * DM; layer = lf >> 1; m = (lf & 1) ? 6 : 0; out = CB + (size_t)lf * 4 * 2 * DFF + n; ostride = 2 * DFF; }
        else { n = rw - 4 * 2 * DFF; wt = (const bf16_t*)(p.ws + WS_WINT) + (size_t)n * DM; layer = 0; m = 3; out = CB + (size_t)16 * 2 * DFF + n; ostride = INW; }
        float a[4] = {0.f, 0.f, 0.f, 0.f};
#pragma unroll
        for (int j = 0; j < 2; ++j) { const int k = 8 * lane + 512 * j; const u32x4 w = *(const u32x4*)(wt + k);
            const float wf[8] = {bflo(w.x), bfhi(w.x), bflo(w.y), bfhi(w.y), bflo(w.z), bfhi(w.z), bflo(w.w), bfhi(w.w)};
#pragma unroll
            for (int b = 0; b < 4; ++b) { const float* sh = modptr(p, layer, b, m) + k; const f32x4 s0 = *(const f32x4*)sh, s1 = *(const f32x4*)(sh + 4);
                a[b] += (wf[0] * s0.x + wf[1] * s0.y) + (wf[2] * s0.z + wf[3] * s0.w) + (wf[4] * s1.x + wf[5] * s1.y) + (wf[6] * s1.z + wf[7] * s1.w); } }
#pragma unroll
        for (int b = 0; b < 4; ++b) { const float t = wave_sum(a[b]); if (lane == 0) out[(size_t)b * ostride] = t; }
    }
}
DEVI void ph_pool(const P& p, const float* xin, float* lds, int bid, int nb) {
    bf16_t* H = (bf16_t*)(p.ws + WS_H); const bf16_t* XB = (const bf16_t*)(p.ws + WS_XB);
    const float* gn = p.norm_g + (1 * 3 + 1) * 1024;
    const int tid = tid_opaque(), wave = tid >> 6, lane = tid & 63;
    float* rsq = lds; float* tile = lds + 128;
    for (int chunk = bid; chunk < T / 64; chunk += nb) {
        const int t0 = chunk * 64, b = t0 / SEQ, s0 = t0 % SEQ;
        __syncthreads();
        for (int i = wave; i < 80; i += 8) { const int s = s0 - 8 + i;
            if (s >= 0 && s < SEQ) { const u32x2* xr = (const u32x2*)(XB + ((size_t)b * SEQ + s) * DM) + lane; float ss = 0.f;
#pragma unroll
                for (int j = 0; j < 4; ++j) { const u32x2 w = xr[64 * j]; const f32x4 v = {bflo(w.x), bfhi(w.x), bflo(w.y), bfhi(w.y)}; ss += (v.x * v.x + v.y * v.y) + (v.z * v.z + v.w * v.w); }
                const float r = rsqrtf(wave_sum(ss) * (1.f / DM) + EPS); if (lane == 0) rsq[i] = r; }
            else if (lane == 0) rsq[i] = 0.f; }
        __syncthreads();
        const float* sc = modptr(p, 1, b, 4);
        for (int g = 0; g < 4; ++g) { const int hw = 1 << g;
#pragma unroll
            for (int k = 0; k < 10; ++k) { const int idx = tid + 512 * k, row = idx >> 6, c4 = idx & 63, s = s0 - 8 + row;
                f32x4 v = {0.f, 0.f, 0.f, 0.f};
                if (s >= 0 && s < SEQ) { const u32x2 w = *((const u32x2*)(XB + ((size_t)b * SEQ + s) * DM + g * 256) + c4); v = (f32x4){bflo(w.x), bfhi(w.x), bflo(w.y), bfhi(w.y)} * rsq[row]; }
                *(f32x4*)(tile + row * 256 + c4 * 4) = v; }
            __syncthreads();
            { const int c = tid & 255, i0 = (tid >> 8) * 32, cg = g * 256 + c;
              const float gg = gn[cg] * (1.f + sc[cg]);
              float S = 0.f;
              for (int k = -hw; k < hw; ++k) S += tile[(i0 + 8 + k) * 256 + c];
              for (int n = 0; n < 32; ++n) { const int idx = i0 + n + 8, sq = s0 + i0 + n; const int lo = max(sq - hw, 0), hi = min(sq + hw, SEQ);
                  const float y = gg * (S / (float)(hi - lo) - tile[idx * 256 + c]);
                  H[(size_t)(t0 + i0 + n) * DM + cg] = (bf16_t)f2bf(y);
                  S += tile[(idx + hw) * 256 + c] - tile[(idx - hw) * 256 + c]; } }
            __syncthreads();
        }
    }
}
struct EpiSwiglu { bf16_t* act; DEVI void operator()(int r, int c, float a, float b) const { act[(size_t)r * DFF + c] = (bf16_t)f2bf(siluf(a) * b); } };
struct EpiResid { const float* xin; float* xout; const float* mod; float coef; const float* bias; const float* scale; int layer, m;
    DEVI void operator()(int r, int c, float a, float) const { const int b = r / SEQ; const float g = mod[((size_t)(layer * 4 + b) * 9 + m) * 1024 + c];
        float v = a; if (bias) v = (v + bias[c]) * scale[c]; const size_t o = (size_t)r * DM + c; xout[o] = xin[o] + coef * g * v; } };
DEVI int unmap_win(int cb) { const int sec = cb >> 9; if (sec == 2 || sec == 5) return cb; const int tile = cb >> 8, w = cb & 255, bj = w >> 7, head = (w >> 5) & 3, j = w & 31; return tile * 256 + head * 64 + bj * 32 + j; }
struct EpiRawQKV { bf16_t* qkv; DEVI void operator()(int r, int c, float a, float) const { qkv[(size_t)r * INW + unmap_win(c)] = (bf16_t)f2bf(a); } };

template <int MODE, class Epi>
DEVI void ph_gemm_naive(const bf16_t* A, int lda, const bf16_t* Bt, int ldb, int M, int N, int K, const Epi& E, float* lds, int bid, int nb) {
    float* As = lds; float* Bs = lds + 32 * 132; float* Bs2 = Bs + 32 * 132;
    const int tid = tid_opaque(), ty = tid >> 5, tx = tid & 31;
    const int nN = N / 128, nM = M / 128;
    for (int tile = bid; tile < nM * nN; tile += nb) {
        const int pm = tile / nN, pn = tile % nN;
        const bf16_t* Ab = A + (size_t)pm * 128 * lda + (MODE == 2 ? (pn >> 1) * 256 : 0);
        const bf16_t* B1 = Bt + (size_t)(MODE == 1 ? pn * 256 : pn * 128) * ldb;
        const bf16_t* B2 = B1 + (size_t)128 * ldb;
        float acc[8][4], acc2[8][4];
#pragma unroll
        for (int i = 0; i < 8; ++i)
#pragma unroll
            for (int j = 0; j < 4; ++j) { acc[i][j] = 0.f; acc2[i][j] = 0.f; }
        for (int k0 = 0; k0 < K; k0 += 32) {
            __syncthreads();
            { const int row = tid >> 2, ks = (tid & 3) * 8;
              const u32x4 va = *(const u32x4*)(Ab + (size_t)row * lda + k0 + ks);
              float* d = As + ks * 132 + row;
              d[0] = bflo(va.x); d[132] = bfhi(va.x); d[2 * 132] = bflo(va.y); d[3 * 132] = bfhi(va.y); d[4 * 132] = bflo(va.z); d[5 * 132] = bfhi(va.z); d[6 * 132] = bflo(va.w); d[7 * 132] = bfhi(va.w);
              const u32x4 vb = *(const u32x4*)(B1 + (size_t)row * ldb + k0 + ks);
              d = Bs + ks * 132 + row;
              d[0] = bflo(vb.x); d[132] = bfhi(vb.x); d[2 * 132] = bflo(vb.y); d[3 * 132] = bfhi(vb.y); d[4 * 132] = bflo(vb.z); d[5 * 132] = bfhi(vb.z); d[6 * 132] = bflo(vb.w); d[7 * 132] = bfhi(vb.w);
              if (MODE == 1) { const u32x4 vc = *(const u32x4*)(B2 + (size_t)row * ldb + k0 + ks);
                  d = Bs2 + ks * 132 + row;
                  d[0] = bflo(vc.x); d[132] = bfhi(vc.x); d[2 * 132] = bflo(vc.y); d[3 * 132] = bfhi(vc.y); d[4 * 132] = bflo(vc.z); d[5 * 132] = bfhi(vc.z); d[6 * 132] = bflo(vc.w); d[7 * 132] = bfhi(vc.w); } }
            __syncthreads();
#pragma unroll 4
            for (int k = 0; k < 32; ++k) {
                const f32x4 a0 = *(const f32x4*)(As + k * 132 + ty * 8), a1 = *(const f32x4*)(As + k * 132 + ty * 8 + 4);
                const f32x4 bv = *(const f32x4*)(Bs + k * 132 + tx * 4);
                const float av[8] = {a0.x, a0.y, a0.z, a0.w, a1.x, a1.y, a1.z, a1.w};
#pragma unroll
                for (int i = 0; i < 8; ++i) { acc[i][0] += av[i] * bv.x; acc[i][1] += av[i] * bv.y; acc[i][2] += av[i] * bv.z; acc[i][3] += av[i] * bv.w; }
                if (MODE == 1) { const f32x4 cv = *(const f32x4*)(Bs2 + k * 132 + tx * 4);
#pragma unroll
                    for (int i = 0; i < 8; ++i) { acc2[i][0] += av[i] * cv.x; acc2[i][1] += av[i] * cv.y; acc2[i][2] += av[i] * cv.z; acc2[i][3] += av[i] * cv.w; } }
            }
        }
#pragma unroll
        for (int i = 0; i < 8; ++i)
#pragma unroll
            for (int j = 0; j < 4; ++j) E(pm * 128 + ty * 8 + i, pn * 128 + tx * 4 + j, acc[i][j], acc2[i][j]);
    }
}
DEVI void ph_qknorm_naive(const P& p, int bid, int nb) {
    bf16_t* QKV = (bf16_t*)(p.ws + WS_ACT); const float* rope = (const float*)(p.ws + WS_ROPE);
    for (int idx = bid * NTHR + tid_opaque(); idx < T * 32; idx += nb * NTHR) {
        const int slot = idx & 31, t = idx >> 5, pos = t % SEQ;
        const int sec4 = slot >> 3, hs = slot & 7;
        const int sec = sec4 < 2 ? sec4 : sec4 + 1;
        bf16_t* v = QKV + (size_t)t * INW + sec * 512 + hs * 64;
        const bool isA = sec4 < 2, isq = (sec4 & 1) == 0;
        const float* g = (isA ? p.a_qk_norm : p.b_qk_norm) + (isq ? 0 : 64);
        float ss = 0.f;
        for (int i = 0; i < 64; ++i) { const float a = bf2f(v[i]); ss += a * a; }
        const float r = rsqrtf(ss * (1.f / 64.f) + EPS), qs = isq ? C2 : 1.f;
        for (int i = 0; i < 32; ++i) { float y1 = bf2f(v[i]) * r * g[i], y2 = bf2f(v[i + 32]) * r * g[i + 32];
            if (isA) { const float cs = rope[(pos * 32 + i) * 2], sn = rope[(pos * 32 + i) * 2 + 1]; const float o1 = y1 * cs - y2 * sn, o2 = y1 * sn + y2 * cs; y1 = o1; y2 = o2; }
            v[i] = (bf16_t)f2bf(y1 * qs); v[i + 32] = (bf16_t)f2bf(y2 * qs); }
    }
}
DEVI void ph_attnA_naive(const P& p, int bid, int nb) {
    const bf16_t* QKV = (const bf16_t*)(p.ws + WS_ACT); float* OA = (float*)(p.ws + WS_OA);
    const int tid = tid_opaque(), qi = tid & 127, quarter = tid >> 7;
    for (int unit = bid; unit < 4 * 4 * 2 * 64; unit += nb) {
        const int qc = unit & 63, mp = (unit >> 6) & 1, h = (unit >> 7) & 3, b = unit >> 9;
        const int row = b * SEQ + qc * 128 + qi;
        float q[64];
        { const u32x4* qp = (const u32x4*)(QKV + (size_t)row * INW + h * 128 + mp * 64);
#pragma unroll
          for (int i = 0; i < 8; ++i) { const u32x4 w = qp[i]; q[8 * i] = bflo(w.x); q[8 * i + 1] = bfhi(w.x); q[8 * i + 2] = bflo(w.y); q[8 * i + 3] = bfhi(w.y); q[8 * i + 4] = bflo(w.z); q[8 * i + 5] = bfhi(w.z); q[8 * i + 6] = bflo(w.w); q[8 * i + 7] = bfhi(w.w); } }
        const bf16_t* kb = QKV + (size_t)b * SEQ * INW + 512 + h * 128 + mp * 64;
        const bf16_t* vb = QKV + (size_t)b * SEQ * INW + 1024 + h * 128 + quarter * 32;
        float m = -INFINITY, l = 0.f, o[32];
#pragma unroll
        for (int i = 0; i < 32; ++i) o[i] = 0.f;
        for (int key = 0; key < SEQ; ++key) {
            const u32x4* kp = (const u32x4*)(kb + (size_t)key * INW);
            float s = 0.f;
#pragma unroll
            for (int i = 0; i < 8; ++i) { const u32x4 w = kp[i];
                s += q[8 * i] * bflo(w.x) + q[8 * i + 1] * bfhi(w.x) + q[8 * i + 2] * bflo(w.y) + q[8 * i + 3] * bfhi(w.y) + q[8 * i + 4] * bflo(w.z) + q[8 * i + 5] * bfhi(w.z) + q[8 * i + 6] * bflo(w.w) + q[8 * i + 7] * bfhi(w.w); }
            const float mn = fmaxf(m, s), corr = exp2f(m - mn), pe = exp2f(s - mn); m = mn; l = l * corr + pe;
            const u32x4* vp = (const u32x4*)(vb + (size_t)key * INW);
#pragma unroll
            for (int i = 0; i < 4; ++i) { const u32x4 w = vp[i];
                o[8 * i] = o[8 * i] * corr + pe * bflo(w.x); o[8 * i + 1] = o[8 * i + 1] * corr + pe * bfhi(w.x); o[8 * i + 2] = o[8 * i + 2] * corr + pe * bflo(w.y); o[8 * i + 3] = o[8 * i + 3] * corr + pe * bfhi(w.y);
                o[8 * i + 4] = o[8 * i + 4] * corr + pe * bflo(w.z); o[8 * i + 5] = o[8 * i + 5] * corr + pe * bfhi(w.z); o[8 * i + 6] = o[8 * i + 6] * corr + pe * bflo(w.w); o[8 * i + 7] = o[8 * i + 7] * corr + pe * bfhi(w.w); }
        }
        const float il = 1.f / l;
        float* op = OA + ((size_t)mp * T + row) * 512 + h * 128 + quarter * 32;
#pragma unroll
        for (int i = 0; i < 32; ++i) op[i] = o[i] * il;
    }
}
DEVI float lam_value(const P& p, int lane) {
    const float* lp = p.a_lambda;
    const float s1 = wave_sum(lp[lane] * lp[64 + lane]), s2 = wave_sum(lp[128 + lane] * lp[192 + lane]);
    return __expf(s1) - __expf(s2) + 0.2f;
}
DEVI void ph_attnA_comb_naive(const P& p, int bid, int nb) {
    const float* OA = (const float*)(p.ws + WS_OA); bf16_t* H = (bf16_t*)(p.ws + WS_H);
    const int wave = tid_opaque() >> 6, lane = tid_opaque() & 63;
    const float lam = lam_value(p, lane);
    for (int it = bid * 8 + wave; it < T * 4; it += nb * 8) {
        const int h = it & 3, t = it >> 2;
        const float* o0 = OA + (size_t)t * 512 + h * 128; const float* o1 = OA + ((size_t)T + t) * 512 + h * 128;
        const float a = o0[lane] - lam * o1[lane], c = o0[lane + 64] - lam * o1[lane + 64];
        const float r = rsqrtf(wave_sum(a * a + c * c) * (1.f / 128.f) + EPS) * 0.8f;
        H[(size_t)t * DM + h * 128 + lane] = (bf16_t)f2bf(a * r * p.a_subln[lane]);
        H[(size_t)t * DM + h * 128 + 64 + lane] = (bf16_t)f2bf(c * r * p.a_subln[64 + lane]);
    }
}
DEVI void ph_natten_naive(const P& p, int bid, int nb) {
    const bf16_t* QKV = (const bf16_t*)(p.ws + WS_ACT); bf16_t* H = (bf16_t*)(p.ws + WS_H);
    for (int idx = bid * NTHR + tid_opaque(); idx < T * 16; idx += nb * NTHR) {
        const int half = idx & 1, h = (idx >> 1) & 7, t = idx >> 4, b = t / SEQ, s = t % SEQ, r = s >> 6, c = s & 63;
        const int rs = min(max(r - 4, 0), 120), cs = min(max(c - 8, 0), 48);
        float q[64], o[32];
        { const u32x4* qp = (const u32x4*)(QKV + (size_t)t * INW + 1536 + h * 64);
#pragma unroll
          for (int i = 0; i < 8; ++i) { const u32x4 w = qp[i]; q[8 * i] = bflo(w.x); q[8 * i + 1] = bfhi(w.x); q[8 * i + 2] = bflo(w.y); q[8 * i + 3] = bfhi(w.y); q[8 * i + 4] = bflo(w.z); q[8 * i + 5] = bfhi(w.z); q[8 * i + 6] = bflo(w.w); q[8 * i + 7] = bfhi(w.w); } }
#pragma unroll
        for (int i = 0; i < 32; ++i) o[i] = 0.f;
        float m = -INFINITY, l = 0.f;
        for (int kr = 0; kr < 8; ++kr)
            for (int kc = 0; kc < 16; ++kc) {
                const int krow = rs + kr, kcol = cs + kc; const size_t tk = (size_t)b * SEQ + krow * 64 + kcol;
                const u32x4* kp = (const u32x4*)(QKV + tk * INW + 2048 + h * 64);
                const u32x4* vp = (const u32x4*)(QKV + tk * INW + 2560 + h * 64 + half * 32);
                float sc = p.b_rpb[(h * 15 + (krow - r + 7)) * 31 + (kcol - c + 15)] * LOG2E;
#pragma unroll
                for (int i = 0; i < 8; ++i) { const u32x4 w = kp[i];
                    sc += q[8 * i] * bflo(w.x) + q[8 * i + 1] * bfhi(w.x) + q[8 * i + 2] * bflo(w.y) + q[8 * i + 3] * bfhi(w.y) + q[8 * i + 4] * bflo(w.z) + q[8 * i + 5] * bfhi(w.z) + q[8 * i + 6] * bflo(w.w) + q[8 * i + 7] * bfhi(w.w); }
                const float mn = fmaxf(m, sc), corr = exp2f(m - mn), pe = exp2f(sc - mn); m = mn; l = l * corr + pe;
#pragma unroll
                for (int i = 0; i < 4; ++i) { const u32x4 w = vp[i];
                    o[8 * i] = o[8 * i] * corr + pe * bflo(w.x); o[8 * i + 1] = o[8 * i + 1] * corr + pe * bfhi(w.x); o[8 * i + 2] = o[8 * i + 2] * corr + pe * bflo(w.y); o[8 * i + 3] = o[8 * i + 3] * corr + pe * bfhi(w.y);
                    o[8 * i + 4] = o[8 * i + 4] * corr + pe * bflo(w.z); o[8 * i + 5] = o[8 * i + 5] * corr + pe * bfhi(w.z); o[8 * i + 6] = o[8 * i + 6] * corr + pe * bflo(w.w); o[8 * i + 7] = o[8 * i + 7] * corr + pe * bfhi(w.w); }
            }
        const float il = 1.f / l;
        u32x4* op = (u32x4*)(H + (size_t)t * DM + 512 + h * 64 + half * 32);
#pragma unroll
        for (int i = 0; i < 4; ++i) { u32x4 w; w.x = pk2(o[8 * i] * il, o[8 * i + 1] * il); w.y = pk2(o[8 * i + 2] * il, o[8 * i + 3] * il); w.z = pk2(o[8 * i + 4] * il, o[8 * i + 5] * il); w.w = pk2(o[8 * i + 6] * il, o[8 * i + 7] * il); op[i] = w; }
    }
}

namespace pg8 {
#define PG8_LAS __attribute__((address_space(3)))
typedef unsigned short bf16_t;
typedef short bf16x8 __attribute__((ext_vector_type(8)));
typedef float f32x4 __attribute__((ext_vector_type(4)));
typedef unsigned u32x4 __attribute__((ext_vector_type(4)));
constexpr int BM = 256, BK = 64, HALF = 128, HTB = HALF * BK * 2  , STAGE_BYTES = 8 * HTB, NXCD = 8, WGM = 8;

__host__ __device__ __forceinline__ int lds_byte(int r, int c) { const int st = (r >> 4) * 2 + (c >> 5), rr = r & 15, cc = c & 31, ob = rr * 64 + cc * 2; return st * 1024 + (ob ^ (((ob >> 9) & 1) << 5)); }
__host__ __device__ __forceinline__ void stage_rc(int b, int& R, int& C) { const int st = b / 1024, sb = b % 1024, swz = sb ^ (((sb >> 9) & 1) << 5); R = (st >> 1) * 16 + swz / 64; C = (st & 1) * 32 + (swz % 64) / 2; }
__host__ __device__ __forceinline__ int perm32(int rho) { const int n = rho >> 4, i = rho & 15; return 8 * (i >> 2) + 4 * n + (i & 3); }

struct Unit { int pm, pn, par; };
struct Gemm { const bf16_t* A; const bf16_t* Bt; int M, N, K, lda, ldb, acol; };

struct StaticOrder {
    int nM, nN, nwg, G, c;
    __host__ __device__ void init(int M, int N, int G_, int c_) { nM = M / BM; nN = N / BM; nwg = nM * nN; G = G_; c = c_; }
    __host__ __device__ bool next(int i, Unit& u) const {
        const long L = (long)i * G + c; if (L >= nwg) return false;
        int wgid = (int)L; { const int q = nwg / NXCD, r = nwg % NXCD, xcd = wgid % NXCD, off = wgid / NXCD; wgid = (xcd < r ? xcd * (q + 1) : r * (q + 1) + (xcd - r) * q) + off; }
        const int nig = WGM * nN, gid = wgid / nig, fm = gid * WGM, gsz = (nM - fm) < WGM ? (nM - fm) : WGM;
        u.pm = fm + ((wgid % nig) % gsz); u.pn = (wgid % nig) / gsz; u.par = i & 1; return true;
    }
    __device__ __forceinline__ void a_ready(const Unit&) const {}
    __device__ __forceinline__ void done(const Unit&) const {}
};
__device__ __forceinline__ unsigned cvt_pk_bf16(float lo, float hi) { unsigned r; asm volatile("v_cvt_pk_bf16_f32 %0, %1, %2" : "=v"(r) : "v"(lo), "v"(hi)); return r; }
typedef float f32x2 __attribute__((ext_vector_type(2)));
template <class Epi, class Sched, bool ALIGN_EPI = false, bool SP2 = false>
__device__ __forceinline__ void gemm_phase(PG8_LAS unsigned char* lds, const Gemm g, const Sched S, const Epi E) {
    const int tid = tid_opaque(), wid = __builtin_amdgcn_readfirstlane(tid >> 6), lane = tid & 63, wr = wid >> 2, wc = wid & 3, fr = lane & 15, fq = lane >> 4;
    const int K = g.K, nt = K / BK;
    unsigned voffA[2], voffB[2];
#pragma unroll
    for (int i = 0; i < 2; ++i) { int R, C; stage_rc(tid * 16 + i * 8192, R, C); const int Rb = Epi::PERM ? ((R & ~31) + perm32(R & 31)) : R;
        voffA[i] = (unsigned)(R * g.lda + C) * 2u; voffB[i] = (unsigned)(Rb * g.ldb + C) * 2u; }
    const size_t kstep = (size_t)(BK * 2);
    const size_t hstepA = (size_t)HALF * g.lda * 2, hstepB = (size_t)HALF * g.ldb * 2;
    const size_t tstepA = 2 * hstepA, tstepB = 2 * hstepB, acolB = (size_t)g.acol * 2;
    const unsigned ldsw = (unsigned)wid * 1024u;
    const int aoff = lds_byte(wr * 64 + fr, fq * 8), boff = lds_byte(wc * 32 + fr, fq * 8);
#define PG8_SA(b, h) (((b) * 2 + (h)) * HTB)
#define PG8_SB(b, h) ((4 + (b) * 2 + (h)) * HTB)
#define PG8_STAGE(bufoff, gbase, voff) do { _Pragma("unroll") for (int _i = 0; _i < 2; ++_i) \
        __builtin_amdgcn_global_load_lds((const unsigned*)((const char*)(gbase) + (voff)[_i]), (PG8_LAS unsigned*)(lds + (bufoff) + ldsw + _i * 8192), 16, 0, 0); } while (0)
#define PG8_LDA(dst, b, h) do { _Pragma("unroll") for (int m = 0; m < 4; ++m) _Pragma("unroll") for (int k = 0; k < 2; ++k) dst[m][k] = *(const PG8_LAS bf16x8*)(lds + PG8_SA(b, h) + aoff + m * 2048 + k * 1024); } while (0)
#define PG8_LDB(dst, b, h) do { _Pragma("unroll") for (int n = 0; n < 2; ++n) _Pragma("unroll") for (int k = 0; k < 2; ++k) dst[n][k] = *(const PG8_LAS bf16x8*)(lds + PG8_SB(b, h) + boff + n * 2048 + k * 1024); } while (0)
#define PG8_MMA(ai, bj, At, Bt) do { __builtin_amdgcn_s_setprio(1); _Pragma("unroll") for (int m = 0; m < 4; ++m) _Pragma("unroll") for (int n = 0; n < 2; ++n) _Pragma("unroll") for (int k = 0; k < 2; ++k) \
        acc[ai][bj][m][n] = __builtin_amdgcn_mfma_f32_16x16x32_bf16(Bt[n][k], At[m][k], acc[ai][bj][m][n], 0, 0, 0); __builtin_amdgcn_s_setprio(0); } while (0)
#define PG8_WAIT_V(n) asm volatile("s_waitcnt vmcnt(" #n ")" ::: "memory")
#define PG8_WAIT_L(n) asm volatile("s_waitcnt lgkmcnt(" #n ")" ::: "memory")
#define PG8_BAR __builtin_amdgcn_s_barrier()
#define PG8_SCHED __builtin_amdgcn_sched_barrier(0)
    Unit cur, nxt; int ui = 0;
    if (!S.next(0, cur)) return;
    f32x4 acc[2][2][4][2];
#pragma unroll
    for (int a = 0; a < 2; ++a)
#pragma unroll
        for (int b = 0; b < 2; ++b)
#pragma unroll
            for (int m = 0; m < 4; ++m)
#pragma unroll
                for (int n = 0; n < 2; ++n) acc[a][b][m][n] = (f32x4){0.f, 0.f, 0.f, 0.f};
    bf16x8 At[4][2], B0[2][2], B1[2][2];
    const char* cA = (const char*)g.A + (size_t)cur.pm * tstepA + (size_t)cur.pn * acolB; const char* cB = (const char*)g.Bt + (size_t)cur.pn * tstepB;
    S.a_ready(cur);
    if constexpr (SP2) {
        PG8_STAGE(PG8_SB(0, 0), cB, voffB); PG8_STAGE(PG8_SB(0, 1), cB + hstepB, voffB); PG8_STAGE(PG8_SA(0, 0), cA, voffA); PG8_STAGE(PG8_SA(0, 1), cA + hstepA, voffA);
        if (wr == 1) PG8_BAR;
        PG8_WAIT_V(2); PG8_BAR;
        PG8_STAGE(PG8_SB(1, 0), cB + kstep, voffB); PG8_STAGE(PG8_SA(1, 0), cA + kstep, voffA); PG8_STAGE(PG8_SB(1, 1), cB + hstepB + kstep, voffB);
        PG8_WAIT_V(6); PG8_BAR;
    } else {
        PG8_STAGE(PG8_SB(0, 0), cB, voffB); PG8_STAGE(PG8_SA(0, 0), cA, voffA); PG8_STAGE(PG8_SB(0, 1), cB + hstepB, voffB); PG8_STAGE(PG8_SA(0, 1), cA + hstepA, voffA);
        if (wr == 1) PG8_BAR;
        PG8_WAIT_V(4); PG8_BAR;
        PG8_STAGE(PG8_SB(1, 0), cB + kstep, voffB); PG8_STAGE(PG8_SA(1, 0), cA + kstep, voffA); PG8_STAGE(PG8_SB(1, 1), cB + hstepB + kstep, voffB);
        PG8_WAIT_V(6); PG8_BAR;
    }
    for (;;) {
        const bool has_next = S.next(ui + 1, nxt);
        const char* nA = has_next ? (const char*)g.A + (size_t)nxt.pm * tstepA + (size_t)nxt.pn * acolB : cA; const char* nB = has_next ? (const char*)g.Bt + (size_t)nxt.pn * tstepB : cB;
        for (int t = 0; t < nt; t += 2) {
            const bool last = (t == nt - 2);
            const char* a1 = cA + (size_t)(t + 1) * kstep;
            const char* a2 = last ? nA : cA + (size_t)(t + 2) * kstep; const char* b2 = last ? nB : cB + (size_t)(t + 2) * kstep;
            const char* a3 = a2 + kstep; const char* b3 = b2 + kstep;
            if (last && has_next) S.a_ready(nxt);
            if constexpr (SP2) {
            PG8_LDB(B0, 0, 0); PG8_LDB(B1, 0, 1); PG8_SCHED; PG8_LDA(At, 0, 0); PG8_STAGE(PG8_SA(1, 1), a1 + hstepA, voffA);
            PG8_WAIT_V(8); PG8_WAIT_L(0); PG8_BAR; PG8_MMA(0, 0, At, B0); PG8_MMA(0, 1, At, B1); PG8_BAR; PG8_SCHED;
            PG8_LDA(At, 0, 1); PG8_STAGE(PG8_SB(0, 0), b2, voffB); PG8_STAGE(PG8_SB(0, 1), b2 + hstepB, voffB); PG8_STAGE(PG8_SA(0, 0), a2, voffA);
            PG8_WAIT_V(8); PG8_WAIT_L(0); PG8_BAR; PG8_MMA(1, 0, At, B0); PG8_MMA(1, 1, At, B1); PG8_BAR; PG8_SCHED;
            PG8_LDB(B0, 1, 0); PG8_LDB(B1, 1, 1); PG8_SCHED; PG8_LDA(At, 1, 0); PG8_STAGE(PG8_SA(0, 1), a2 + hstepA, voffA);
            PG8_WAIT_V(8); PG8_WAIT_L(0); PG8_BAR; PG8_MMA(0, 0, At, B0); PG8_MMA(0, 1, At, B1); PG8_BAR; PG8_SCHED;
            PG8_LDA(At, 1, 1); PG8_STAGE(PG8_SB(1, 0), b3, voffB); PG8_STAGE(PG8_SB(1, 1), b3 + hstepB, voffB); PG8_STAGE(PG8_SA(1, 0), a3, voffA);
            PG8_WAIT_V(8); PG8_WAIT_L(0); PG8_BAR; PG8_MMA(1, 0, At, B0); PG8_MMA(1, 1, At, B1); PG8_BAR; PG8_SCHED;
            } else {
            PG8_LDB(B0, 0, 0); PG8_SCHED; PG8_LDA(At, 0, 0); PG8_STAGE(PG8_SA(1, 1), a1 + hstepA, voffA);
            PG8_WAIT_L(8); PG8_BAR; PG8_WAIT_L(0); PG8_MMA(0, 0, At, B0); PG8_BAR; PG8_SCHED;
            PG8_LDB(B1, 0, 1); PG8_STAGE(PG8_SB(0, 0), b2, voffB);
            PG8_BAR; PG8_WAIT_L(0); PG8_MMA(0, 1, At, B1); PG8_BAR;
            PG8_LDA(At, 0, 1); PG8_STAGE(PG8_SA(0, 0), a2, voffA);
            PG8_BAR; PG8_WAIT_L(0); PG8_MMA(1, 0, At, B0); PG8_BAR; PG8_SCHED;
            PG8_STAGE(PG8_SB(0, 1), b2 + hstepB, voffB);
            PG8_WAIT_V(6); PG8_BAR; PG8_MMA(1, 1, At, B1); PG8_BAR;
            PG8_LDB(B0, 1, 0); PG8_SCHED; PG8_LDA(At, 1, 0); PG8_STAGE(PG8_SA(0, 1), a2 + hstepA, voffA);
            PG8_WAIT_L(8); PG8_BAR; PG8_WAIT_L(0); PG8_MMA(0, 0, At, B0); PG8_BAR; PG8_SCHED;
            PG8_LDB(B1, 1, 1); PG8_STAGE(PG8_SB(1, 0), b3, voffB);
            PG8_BAR; PG8_WAIT_L(0); PG8_MMA(0, 1, At, B1); PG8_BAR;
            PG8_LDA(At, 1, 1); PG8_STAGE(PG8_SA(1, 0), a3, voffA);
            PG8_BAR; PG8_WAIT_L(0); PG8_MMA(1, 0, At, B0); PG8_BAR; PG8_SCHED;
            PG8_STAGE(PG8_SB(1, 1), b3 + hstepB, voffB);
            PG8_WAIT_V(6); PG8_BAR; PG8_MMA(1, 1, At, B1); PG8_BAR;
            }
        }
        if constexpr (ALIGN_EPI) { if (wr == 0) PG8_BAR; }
        if constexpr (!Epi::AFTER_DRAIN) { E(acc, cur, wr, wc, fr, fq); S.done(cur); }
        if (!has_next) break;
#pragma unroll
        for (int a = 0; a < 2; ++a)
#pragma unroll
            for (int b = 0; b < 2; ++b)
#pragma unroll
                for (int m = 0; m < 4; ++m)
#pragma unroll
                    for (int n = 0; n < 2; ++n) acc[a][b][m][n] = (f32x4){0.f, 0.f, 0.f, 0.f};
        cur = nxt; cA = nA; cB = nB; ++ui;
        if constexpr (ALIGN_EPI) { if (wr == 1) PG8_BAR; }
    }
    PG8_WAIT_V(0);
    if constexpr (!ALIGN_EPI) { if (wr == 0) PG8_BAR; }
    PG8_BAR;
    if constexpr (Epi::AFTER_DRAIN) { E.fused(acc, cur, wr, wc, fr, fq, lds, wid, lane); S.done(cur); }
#undef PG8_SA
#undef PG8_SB
#undef PG8_STAGE
#undef PG8_LDA
#undef PG8_LDB
#undef PG8_MMA
#undef PG8_WAIT_V
#undef PG8_WAIT_L
#undef PG8_BAR
#undef PG8_SCHED
}
}

namespace pg8 {
DEVI float fast_silu(float a) { return a * __builtin_amdgcn_rcpf(1.f + __builtin_amdgcn_exp2f(-a * LOG2E)); }
DEVI u32x4 pack8(const f32x4 a, const f32x4 b) { u32x4 w; w.x = cvt_pk_bf16(a[0], a[1]); w.y = cvt_pk_bf16(a[2], a[3]); w.z = cvt_pk_bf16(b[0], b[1]); w.w = cvt_pk_bf16(b[2], b[3]); return w; }
struct EpiSwigluF { static constexpr bool PERM = true, AFTER_DRAIN = false; bf16_t* act; const PG8_LAS float* xl;
    DEVI void operator()(const f32x4 (&acc)[2][2][4][2], const Unit& u, int wr, int wc, int fr, int fq) const {
        const int row0 = u.pm * BM + wr * 64 + fr, col0 = u.pn * 128 + wc * 32 + 8 * fq;
        const PG8_LAS float* sl = xl + u.par * 512 + wr * 64 + fr; const PG8_LAS float* cp = xl + u.par * 512 + 256 + wc * 32 + 8 * fq;
        const f32x4 c00 = *(const PG8_LAS f32x4*)cp, c01 = *(const PG8_LAS f32x4*)(cp + 4), c10 = *(const PG8_LAS f32x4*)(cp + HALF), c11 = *(const PG8_LAS f32x4*)(cp + HALF + 4);
#pragma unroll
        for (int ai = 0; ai < 2; ++ai)
#pragma unroll
            for (int m = 0; m < 4; ++m) { const int row = row0 + ai * HALF + m * 16; bf16_t* rowp = act + (size_t)row * DFF + col0;
                const float r = rsqrtf(sl[ai * HALF + m * 16] * (1.f / DM) + EPS);
                const f32x4 a0 = acc[ai][0][m][0] * r + c00, a1 = acc[ai][0][m][1] * r + c01, b0 = acc[ai][1][m][0] * r + c10, b1 = acc[ai][1][m][1] * r + c11;
                f32x4 o0, o1;
#pragma unroll
                for (int i = 0; i < 4; ++i) { o0[i] = fast_silu(a0[i]) * b0[i]; o1[i] = fast_silu(a1[i]) * b1[i]; }
                *(u32x4*)rowp = pack8(o0, o1); }
    } };
struct EpiResidF { static constexpr bool PERM = false, AFTER_DRAIN = false;
    const float* xin; float* xout; const float* gate; const float* bias; const float* scale; int half;
    bf16_t* xt; const float* gn; const float* scn; float* ss;
    const bf16_t* xinb; bf16_t* xoutb;
    DEVI void operator()(const f32x4 (&acc)[2][2][4][2], const Unit& u, int wr, int wc, int fr, int fq) const {
        const int row0 = u.pm * BM + wr * 64 + fr, col0 = u.pn * BM + wc * 32 + 4 * fq, b = u.pm >> 5;
        const float* gp = gate + (size_t)b * 9 * 1024 + col0; const float coef = half ? 0.5f : 1.0f;
        float rs[2][4];
#pragma unroll
        for (int ai = 0; ai < 2; ++ai)
#pragma unroll
            for (int m = 0; m < 4; ++m) rs[ai][m] = 0.f;
#pragma unroll
        for (int bj = 0; bj < 2; ++bj) {
            u32x2 xw[2][2][4];
#pragma unroll
            for (int n = 0; n < 2; ++n) { const int co = bj * HALF + n * 16;
                if (bj == 1 ? (n == 0) : true) {
#pragma unroll
                    for (int nn = 0; nn < 2; ++nn) if (bj == 1 || nn == n) {
#pragma unroll
                        for (int ai = 0; ai < 2; ++ai)
#pragma unroll
                            for (int m = 0; m < 4; ++m) xw[nn][ai][m] = *(const u32x2*)(xinb + (size_t)(row0 + ai * HALF + m * 16) * DM + col0 + bj * HALF + nn * 16); } }
                f32x4 gv = *(const f32x4*)(gp + co) * coef, bv = {0.f, 0.f, 0.f, 0.f}, ggv = {0.f, 0.f, 0.f, 0.f};
                if (bias) { const f32x4 sv = *(const f32x4*)(scale + col0 + co); bv = *(const f32x4*)(bias + col0 + co) * sv * gv; gv = gv * sv; }
                if (xt) ggv = *(const f32x4*)(gn + col0 + co) * (*(const f32x4*)(scn + (size_t)b * 9 * 1024 + col0 + co) + 1.f);
#pragma unroll
                for (int ai = 0; ai < 2; ++ai)
#pragma unroll
                    for (int m = 0; m < 4; ++m) { const size_t off = (size_t)(row0 + ai * HALF + m * 16) * DM + col0 + co;
                        const u32x2 w0 = xw[n][ai][m];
                        const f32x4 xv = {__uint_as_float(w0.x << 16), __uint_as_float(w0.x & 0xffff0000u), __uint_as_float(w0.y << 16), __uint_as_float(w0.y & 0xffff0000u)};
                        const f32x4 xn = xv + bv + gv * acc[ai][bj][m][n];
                        if (xoutb) { u32x2 w; w.x = cvt_pk_bf16(xn[0], xn[1]); w.y = cvt_pk_bf16(xn[2], xn[3]); *(u32x2*)(xoutb + off) = w; }
                        else *(f32x4*)(xout + off) = xn;
                        if (xt) { rs[ai][m] += (xn[0] * xn[0] + xn[1] * xn[1]) + (xn[2] * xn[2] + xn[3] * xn[3]); const f32x4 y = xn * ggv;
                            u32x2 w; w.x = cvt_pk_bf16(y[0], y[1]); w.y = cvt_pk_bf16(y[2], y[3]); *(u32x2*)(xt + off) = w; } }
                if (bj == 0 || n == 1) asm volatile("" ::: "memory"); } }
        if (xt) {
#pragma unroll
            for (int ai = 0; ai < 2; ++ai)
#pragma unroll
                for (int m = 0; m < 4; ++m) { float t = rs[ai][m]; t += swz_xor<16>(t); t = add32(t);
                    if (fq == 0) unsafeAtomicAdd(ss + row0 + ai * HALF + m * 16, t); } }
    } };
struct EpiQKV { static constexpr bool PERM = true, AFTER_DRAIN = false; bf16_t* qkv; const float* rope; const float* a_qk; const float* b_qk; const PG8_LAS float* xl;
    DEVI void operator()(const f32x4 (&acc)[2][2][4][2], const Unit& u, int wr, int wc, int fr, int fq) const {
        const int sec = u.pn >> 1, row0 = u.pm * BM + wr * 64 + fr;
        const PG8_LAS float* sl = xl + u.par * 512 + wr * 64 + fr; const PG8_LAS float* cp = xl + u.par * 512 + 256 + wc * 32 + 8 * fq;
        if (sec == 2 || sec == 5) {
            const f32x4 cv[2][2] = {{*(const PG8_LAS f32x4*)cp, *(const PG8_LAS f32x4*)(cp + 4)}, {*(const PG8_LAS f32x4*)(cp + HALF), *(const PG8_LAS f32x4*)(cp + HALF + 4)}};
            const int col0 = u.pn * BM + wc * 32 + 8 * fq;
#pragma unroll
            for (int ai = 0; ai < 2; ++ai)
#pragma unroll
                for (int m = 0; m < 4; ++m) { const int row = row0 + ai * HALF + m * 16; bf16_t* rowp = qkv + (size_t)row * INW + col0;
                    const float r = rsqrtf(sl[ai * HALF + m * 16] * (1.f / DM) + EPS);
#pragma unroll
                    for (int bj = 0; bj < 2; ++bj) *(u32x4*)(rowp + bj * HALF) = pack8(acc[ai][bj][m][0] * r + cv[bj][0], acc[ai][bj][m][1] * r + cv[bj][1]); }
        } else {
            const bool isA = sec < 2, isq = (sec == 0 || sec == 3);
            const float* g = (isA ? a_qk : b_qk) + (isq ? 0 : 64) + 8 * fq;
            const f32x4 g1[2] = {*(const f32x4*)g, *(const f32x4*)(g + 4)}, g2[2] = {*(const f32x4*)(g + 32), *(const f32x4*)(g + 36)};
            const float qs = isq ? C2 : 1.f;
#pragma unroll
            for (int ai = 0; ai < 2; ++ai)
#pragma unroll
                for (int m = 0; m < 4; ++m) { const int row = row0 + ai * HALF + m * 16;
                    const float rr = rsqrtf(sl[ai * HALF + m * 16] * (1.f / DM) + EPS);
                    const f32x4 cv[2][2] = {{*(const PG8_LAS f32x4*)cp, *(const PG8_LAS f32x4*)(cp + 4)}, {*(const PG8_LAS f32x4*)(cp + HALF), *(const PG8_LAS f32x4*)(cp + HALF + 4)}};
                    f32x4 y1[2], y2[2]; float sq = 0.f;
#pragma unroll
                    for (int n = 0; n < 2; ++n) { y1[n] = acc[ai][0][m][n] * rr + cv[0][n]; y2[n] = acc[ai][1][m][n] * rr + cv[1][n];
                        sq += (y1[n][0] * y1[n][0] + y1[n][1] * y1[n][1]) + (y1[n][2] * y1[n][2] + y1[n][3] * y1[n][3]) + (y2[n][0] * y2[n][0] + y2[n][1] * y2[n][1]) + (y2[n][2] * y2[n][2] + y2[n][3] * y2[n][3]); }
                    sq += swz_xor<16>(sq); sq = add32(sq);
                    const float r = rsqrtf(sq * (1.f / 64.f) + EPS);
#pragma unroll
                    for (int n = 0; n < 2; ++n) { y1[n] = y1[n] * r * g1[n]; y2[n] = y2[n] * r * g2[n]; }
                    if (isA) { const f32x4* rp = (const f32x4*)(rope + ((size_t)(row & (SEQ - 1)) * 32 + 8 * fq) * 2);
                        const f32x4 t0 = rp[0], t1 = rp[1], t2 = rp[2], t3 = rp[3];
                        const float cs[8] = {t0[0], t0[2], t1[0], t1[2], t2[0], t2[2], t3[0], t3[2]}, sn[8] = {t0[1], t0[3], t1[1], t1[3], t2[1], t2[3], t3[1], t3[3]};
#pragma unroll
                        for (int n = 0; n < 2; ++n)
#pragma unroll
                            for (int i = 0; i < 4; ++i) { const float a = y1[n][i], b2 = y2[n][i]; y1[n][i] = a * cs[4 * n + i] - b2 * sn[4 * n + i]; y2[n][i] = a * sn[4 * n + i] + b2 * cs[4 * n + i]; } }
#pragma unroll
                    for (int n = 0; n < 2; ++n) { y1[n] = y1[n] * qs; y2[n] = y2[n] * qs; }
                    bf16_t* dst = qkv + (size_t)row * INW + u.pn * BM + wc * 64 + 8 * fq;
                    *(u32x4*)dst = pack8(y1[0], y1[1]); *(u32x4*)(dst + 32) = pack8(y2[0], y2[1]); asm volatile("" ::: "memory"); }
        }
    } };
}


namespace att {
#define ALAS __attribute__((address_space(3)))
typedef short bf16x8 __attribute__((ext_vector_type(8)));
typedef short s16x4 __attribute__((ext_vector_type(4)));
typedef short v4i16_t __attribute__((ext_vector_type(4)));
typedef float f32x16 __attribute__((ext_vector_type(16)));
constexpr int SLOT = 16384, VOFF = 3 * SLOT, NT = SEQ / 64;
DEVI int crow(int r, int hi) { return (r & 3) + 8 * (r >> 2) + 4 * hi; }
DEVI s16x4 vtr(const ALAS unsigned char* p) { return __builtin_bit_cast(s16x4, __builtin_amdgcn_ds_read_tr16_b64_v4i16((ALAS v4i16_t*)p)); }
typedef float f32x2_t __attribute__((ext_vector_type(2))); typedef __bf16 bf16x2_t __attribute__((ext_vector_type(2)));
DEVI unsigned cvtpk(float lo, float hi) { f32x2_t v = {lo, hi}; bf16x2_t b = __builtin_convertvector(v, bf16x2_t); return __builtin_bit_cast(unsigned, b); }
DEVI void glds16(const void* g, unsigned lds_dst) {
    unsigned keep; asm volatile("s_mov_b32 %0, m0\n\ts_mov_b32 m0, %2\n\ts_nop 0\n\tglobal_load_lds_dwordx4 %1, off\n\ts_mov_b32 m0, %0" : "=&s"(keep) : "v"(g), "s"(lds_dst) : "memory"); }

template <bool SH> DEVI void attnA_body(const P& p, bf16_t* H, ALAS unsigned char* lds, int bid, int nb, const float shf) {
    const int tid = tid_opaque(), lane = tid & 63, r32 = lane & 31, hi = lane >> 5;
    const int wid = __builtin_amdgcn_readfirstlane(tid >> 6), qsub = wid >> 1, mp = wid & 1;
    const bf16_t* QKV = (const bf16_t*)(p.ws + WS_ACT);
    const float lam = lam_value(p, lane);
    const int vlane = ((lane >> 4) & 1) * 32 + (lane & 3) * 8 + (4 * hi + ((lane & 15) >> 2)) * 64;
    const int ksw = (r32 >> 2) & 3, kbase = (r32 >> 4) * 4096 + mp * 2048 + (r32 & 15) * 64, kx0 = ((hi) ^ ksw) * 16, kx1 = ((2 + hi) ^ ksw) * 16;
    const unsigned lds0 = (unsigned)(uintptr_t)lds;
    for (int i = 0;; ++i) {
        const int u = i * nb + bid; if (u >= 1024) break;
        int bh, qblk;
        if (nb == 256) { bh = (bid & 7) * 2 + (i >> 1); qblk = (i & 1) * 32 + (bid >> 3); } else { bh = u >> 6; qblk = u & 63; }
        const int b = bh >> 2, h = bh & 3; const size_t rowbase = (size_t)b * SEQ; const int q0 = qblk * 128;
        bf16x8 qr[4];
        { const bf16_t* Qw = QKV + (rowbase + q0 + qsub * 32 + r32) * INW + h * 128 + mp * 64 + hi * 8;
#pragma unroll
          for (int d0 = 0; d0 < 4; ++d0) qr[d0] = *(const bf16x8*)(Qw + d0 * 16); }
        asm volatile("s_waitcnt vmcnt(0)" : "+v"(qr[0]), "+v"(qr[1]), "+v"(qr[2]), "+v"(qr[3]) :: "memory");
        const bf16_t* ksrc = QKV + (rowbase + (wid & 3) * 16 + (lane >> 2)) * INW + 512 + h * 128 + (wid >> 2) * 64 + (((lane & 3) ^ ((lane >> 4) & 3)) * 8);
        const bf16_t* vsrc = QKV + (rowbase + 16 * (wid & 3) + (lane >> 2)) * INW + 1024 + h * 128 + (wid >> 2) * 64 + (lane & 3) * 8;
        const unsigned kdst = __builtin_amdgcn_readfirstlane(lds0 + ((wid & 3) * 4 + (wid >> 2) * 2) * 1024), vdst = __builtin_amdgcn_readfirstlane(lds0 + VOFF + ((wid >> 2) * 8 + (wid & 3)) * 1024);
#define ATT_ISSUE_K(t, so) do { const size_t go_ = (size_t)(t) * 64 * INW; glds16(ksrc + go_, kdst + (so)); glds16(ksrc + go_ + 32, kdst + (so) + 1024); } while (0)
#define ATT_ISSUE_V(t, so) do { const size_t go_ = (size_t)(t) * 64 * INW; glds16(vsrc + go_, vdst + (so)); glds16(vsrc + go_ + 32, vdst + (so) + 4096); } while (0)
#define ATT_WAITBAR(n) asm volatile("s_waitcnt vmcnt(" #n ") lgkmcnt(0)\n\ts_barrier" ::: "memory")
#define ATT_SB() __builtin_amdgcn_sched_barrier(0)
#define ATT_KLOAD(so) do { const ALAS unsigned char* Ks = lds + (so) + kbase; \
        _Pragma("unroll") for (int d0 = 0; d0 < 4; ++d0) { const int xo_ = (d0 >> 1) * 1024 + ((d0 & 1) ? kx1 : kx0); kf[2 * d0] = *(const ALAS bf16x8*)(Ks + xo_); kf[2 * d0 + 1] = *(const ALAS bf16x8*)(Ks + xo_ + 8192); } } while (0)
#define ATT_QKM() do { \
        _Pragma("unroll") for (int r = 0; r < 16; ++r) { p0[r] = 0.f; p1[r] = 0.f; } \
        _Pragma("unroll") for (int d0 = 0; d0 < 4; ++d0) { \
            p0 = __builtin_amdgcn_mfma_f32_32x32x16_bf16(kf[2 * d0], qr[d0], p0, 0, 0, 0); p1 = __builtin_amdgcn_mfma_f32_32x32x16_bf16(kf[2 * d0 + 1], qr[d0], p1, 0, 0, 0); } } while (0)
#define ATT_VLOAD(buf, so, cb) do { const ALAS unsigned char* Vs = lds + VOFF + (so) + vlane + (cb) * 4096; \
        _Pragma("unroll") for (int ks = 0; ks < 4; ++ks) { buf[2 * ks] = vtr(Vs + ks * 1024); buf[2 * ks + 1] = vtr(Vs + ks * 1024 + 512); } } while (0)
#define ATT_PVG(PW, buf, cb) do { _Pragma("unroll") for (int ks = 0; ks < 4; ++ks) { \
        const bf16x8 vf = (bf16x8){buf[2 * ks][0], buf[2 * ks][1], buf[2 * ks][2], buf[2 * ks][3], buf[2 * ks + 1][0], buf[2 * ks + 1][1], buf[2 * ks + 1][2], buf[2 * ks + 1][3]}; \
        o[cb] = __builtin_amdgcn_mfma_f32_32x32x16_bf16(__builtin_bit_cast(bf16x8, PW[ks]), vf, o[cb], 0, 0, 0); } } while (0)
#define ATT_EXPG(PN, P, B, k) do { float e_[8]; _Pragma("unroll") for (int r = 0; r < 8; ++r) { e_[r] = __builtin_amdgcn_exp2f(SH ? P[(B) + r] - shf : P[(B) + r]); } \
        _Pragma("unroll") for (int r = 0; r < 8; ++r) lsum += e_[r];     \
        PN[k] = (u32x4){cvtpk(e_[0], e_[1]), cvtpk(e_[2], e_[3]), cvtpk(e_[4], e_[5]), cvtpk(e_[6], e_[7])}; } while (0)
#define ATT_STEP(PO, PN, sknext, sv, ldk) do { ATT_QKM(); ATT_VLOAD(va, sv, 0); ATT_SB(); \
        ATT_VLOAD(vb, sv, 1); ATT_PVG(PO, va, 0); ATT_EXPG(PN, p0, 0, 0); ATT_SB(); \
        ATT_VLOAD(va, sv, 2); ATT_PVG(PO, vb, 1); ATT_EXPG(PN, p0, 8, 1); ATT_SB(); \
        ATT_VLOAD(vb, sv, 3); ATT_PVG(PO, va, 2); ATT_EXPG(PN, p1, 0, 2); ATT_SB(); \
        if (ldk) ATT_KLOAD(sknext); \
        ATT_PVG(PO, vb, 3); ATT_EXPG(PN, p1, 8, 3); ATT_SB(); } while (0)
#define ATT_ROT() do { const int tmp_ = s0; s0 = s1; s1 = s2; s2 = tmp_; } while (0)
        ATT_ISSUE_K(0, 0); ATT_ISSUE_K(1, SLOT); ATT_ISSUE_V(0, 0); ATT_ISSUE_K(2, 2 * SLOT);
        f32x16 o[4], p0, p1; u32x4 pwa[4], pwb[4]; s16x4 va[8], vb[8]; bf16x8 kf[8];
#pragma unroll
        for (int cb = 0; cb < 4; ++cb)
#pragma unroll
            for (int r = 0; r < 16; ++r) o[cb][r] = 0.f;
        float lsum = 0.f;
        ATT_WAITBAR(6); ATT_KLOAD(0);
        ATT_WAITBAR(4); ATT_ISSUE_K(3, 0); ATT_ISSUE_V(1, SLOT);
        ATT_QKM(); ATT_KLOAD(SLOT); ATT_EXPG(pwa, p0, 0, 0); ATT_EXPG(pwa, p0, 8, 1); ATT_EXPG(pwa, p1, 0, 2); ATT_EXPG(pwa, p1, 8, 3);
        int s0 = SLOT, s1 = 2 * SLOT, s2 = 0;
        for (int t = 1; t < NT - 4; t += 2) {
            ATT_WAITBAR(4); ATT_ISSUE_K(t + 3, s0); ATT_ISSUE_V(t + 1, s1);
            ATT_STEP(pwa, pwb, s1, s2, true); ATT_ROT();
            ATT_WAITBAR(4); ATT_ISSUE_K(t + 4, s0); ATT_ISSUE_V(t + 2, s1);
            ATT_STEP(pwb, pwa, s1, s2, true); ATT_ROT();
        }
        ATT_WAITBAR(4); ATT_ISSUE_V(NT - 2, s1);
        ATT_STEP(pwa, pwb, s1, s2, true); ATT_ROT();
        ATT_WAITBAR(2); ATT_ISSUE_V(NT - 1, s1);
        ATT_STEP(pwb, pwa, s1, s2, true); ATT_ROT();
        ATT_WAITBAR(2);
        ATT_STEP(pwa, pwb, s1, s2, false);
        ATT_WAITBAR(0);
        ATT_VLOAD(va, s0, 0); ATT_VLOAD(vb, s0, 1); ATT_PVG(pwb, va, 0); ATT_PVG(pwb, vb, 1); ATT_VLOAD(va, s0, 2); ATT_VLOAD(vb, s0, 3); ATT_PVG(pwb, va, 2); ATT_PVG(pwb, vb, 3);
#undef ATT_ROT
#undef ATT_ISSUE_K
#undef ATT_ISSUE_V
#undef ATT_WAITBAR
#undef ATT_SB
#undef ATT_KLOAD
#undef ATT_QKM
#undef ATT_VLOAD
#undef ATT_PVG
#undef ATT_EXPG
#undef ATT_STEP
        lsum = add32(lsum);
        float linv = 1.f / lsum; if (mp == 1) linv *= lam;
#pragma unroll
        for (int r = 0; r < 16; ++r) { const float sc = __shfl(linv, crow(r, hi));
#pragma unroll
            for (int cb = 0; cb < 4; ++cb) o[cb][r] *= sc; }
        asm volatile("s_waitcnt lgkmcnt(0)\n\ts_barrier" ::: "memory");
        ALAS float* xb = (ALAS float*)lds + qsub * 4096;
        if (mp == 1) {
#pragma unroll
            for (int r = 0; r < 16; ++r)
#pragma unroll
                for (int cb = 0; cb < 4; ++cb) xb[crow(r, hi) * 128 + cb * 32 + r32] = o[cb][r];
        }
        asm volatile("s_waitcnt lgkmcnt(0)\n\ts_barrier" ::: "memory");
        if (mp == 0) {
            float gsub[4];
#pragma unroll
            for (int cb = 0; cb < 4; ++cb) gsub[cb] = p.a_subln[cb * 32 + r32] * 0.8f;
#pragma unroll
            for (int r = 0; r < 16; ++r) { float ss = 0.f;
#pragma unroll
                for (int cb = 0; cb < 4; ++cb) { o[cb][r] -= xb[crow(r, hi) * 128 + cb * 32 + r32]; ss += o[cb][r] * o[cb][r]; }
                ss += swz_xor<1>(ss); ss += swz_xor<2>(ss); ss += swz_xor<4>(ss); ss += swz_xor<8>(ss); ss += swz_xor<16>(ss);
                const float rn = rsqrtf(ss * (1.f / 128.f) + EPS);
                bf16_t* orow = H + (rowbase + q0 + qsub * 32 + crow(r, hi)) * DM + h * 128 + r32;
#pragma unroll
                for (int cb = 0; cb < 4; ++cb) orow[cb * 32] = (bf16_t)f2bf(o[cb][r] * rn * gsub[cb]); }
        }
        asm volatile("s_waitcnt lgkmcnt(0)\n\ts_barrier" ::: "memory");
    }
}
DEVI void ph_attnA(const P& p, bf16_t* H, ALAS unsigned char* lds, int bid, int nb) {
    const int lane = tid_opaque() & 63;
    float gq = fabsf(p.a_qk_norm[lane]), gk = fabsf(p.a_qk_norm[64 + lane]);
    gq = wave_max(gq); gk = wave_max(gk);
    const float shf = __uint_as_float(__builtin_amdgcn_readfirstlane(__float_as_uint(fmaxf(8.f * LOG2E * gq * gk - 64.f, 0.f))));
    if (shf != 0.f) attnA_body<true>(p, H, lds, bid, nb, shf); else attnA_body<false>(p, H, lds, bid, nb, 0.f);
}
}


#ifndef DBG
#define DBG 1
#endif
DEVI void ph_dbg_cmp(const P& p, int bid, int nb) {
    const bf16_t* H = (const bf16_t*)(p.ws + WS_H); const bf16_t* H2 = (const bf16_t*)(p.ws + WS_OA); const bf16_t* H3 = H2 + (size_t)T * DM;
    float d0 = 0.f, d1 = 0.f;
    for (size_t i = (size_t)bid * NTHR + tid_opaque(); i < (size_t)T * 512; i += (size_t)nb * NTHR) { const size_t t = i >> 9, c = i & 511, o = t * DM + c;
        const float a = bf2f(H[o]), b = bf2f(H2[o]), c3 = bf2f(H3[o]); float e0 = fabsf(a - b), e1 = fabsf(b - c3);
        if (!(e0 == e0)) e0 = 1e6f; if (!(e1 == e1)) e1 = 1e6f;
        d0 = fmaxf(d0, e0); d1 = fmaxf(d1, e1); }
    d0 = wave_max(d0); d1 = wave_max(d1);
    if ((tid_opaque() & 63) == 0) { unsigned* w = (unsigned*)(p.ws + WS_DBGW); atomicMax(w, __float_as_uint(d0)); atomicMax(w + 1, __float_as_uint(d1)); }
}


namespace pg8 {
struct PrefetchOrder : StaticOrder {
    const float* ss; const float* cb; int cbstride; unsigned ldsx;
    DEVI void a_ready(const Unit& u) const {
        const int tid_ = tid_opaque(), wid = __builtin_amdgcn_readfirstlane(tid_ >> 6), lane = tid_ & 63;
        if (wid == 0) att::glds16(ss + (size_t)u.pm * BM + lane * 4, ldsx + u.par * 2048);
        else if (wid == 1) att::glds16(cb + (size_t)(u.pm >> 5) * cbstride + u.pn * BM + lane * 4, ldsx + u.par * 2048 + 1024);
    }
};
}

namespace nat {
using att::bf16x8; using att::s16x4; using att::vtr; using att::cvtpk; using att::glds16;
typedef float f32x4v __attribute__((ext_vector_type(4)));
constexpr int XOFF = 65536;
DEVI void ph_natten(const P& p, ALAS unsigned char* lds, int bid, int nb) {
    const int tid = tid_opaque(), lane = tid & 63, t16 = lane & 15, g = lane >> 4;
    const int wid = __builtin_amdgcn_readfirstlane(tid >> 6), j = wid & 3, hh = wid >> 2;
    const bf16_t* QKV = (const bf16_t*)(p.ws + WS_ACT); bf16_t* H = (bf16_t*)(p.ws + WS_H);
    const unsigned lds0 = (unsigned)(uintptr_t)lds;
    const int c0 = (j == 0) ? 0 : (j == 1) ? 8 : (j == 2) ? 24 : 32;
    const int qc = 16 * j + t16, cs = min(max(qc - 8, 0), 48);
    const int nunits = NBATCH * 8 * 128, per = (nunits + nb - 1) / nb;
    int cur_bh = -1, cur_rs = -100;
    for (int i = 0; i < per; ++i) {
        const int u = bid * per + i; if (u >= nunits) break;
        const int bh = u >> 7, r = u & 127, b = bh >> 3, h = bh & 7, rs = min(max(r - 4, 0), 120);
        const size_t rowbase = (size_t)b * SEQ;
        { const bf16_t* vrow0 = QKV + (rowbase + (lane >> 3)) * INW + 2560 + h * 64 + (lane & 7) * 8;
          if (bh != cur_bh || rs != cur_rs + 1) {
              if (bh != cur_bh || rs != cur_rs) {
                  const int krow = rs + wid; const unsigned vdst = __builtin_amdgcn_readfirstlane(lds0 + (krow & 7) * 8192);
#pragma unroll
                  for (int pc = 0; pc < 8; ++pc) glds16(vrow0 + (size_t)(krow * 64 + pc * 8) * INW, vdst + pc * 1024); }
          } else { const int krow = rs + 7; glds16(vrow0 + (size_t)(krow * 64 + wid * 8) * INW, __builtin_amdgcn_readfirstlane(lds0 + (krow & 7) * 8192 + wid * 1024)); }
          cur_bh = bh; cur_rs = rs; }
        bf16x8 qf[2];
        { const bf16_t* qp = QKV + (rowbase + (size_t)r * 64 + qc) * INW + 1536 + h * 64 + 8 * g; qf[0] = *(const bf16x8*)qp; qf[1] = *(const bf16x8*)(qp + 32); }
        f32x4v s[8];
        const bf16_t* kbase = QKV + (rowbase + (size_t)(rs + 4 * hh) * 64 + c0 + t16) * INW + 2048 + h * 64 + 8 * g;
#pragma unroll
        for (int tl = 0; tl < 8; ++tl) { const bf16_t* kp = kbase + (size_t)((tl >> 1) * 64 + (tl & 1) * 16) * INW;
            const bf16x8 k0 = *(const bf16x8*)kp, k1 = *(const bf16x8*)(kp + 32);
            f32x4v a = {0.f, 0.f, 0.f, 0.f};
            a = __builtin_amdgcn_mfma_f32_16x16x32_bf16(k0, qf[0], a, 0, 0, 0); a = __builtin_amdgcn_mfma_f32_16x16x32_bf16(k1, qf[1], a, 0, 0, 0); s[tl] = a; }
        float lsum = 0.f; unsigned pw[4][4];
#pragma unroll
        for (int kr = 0; kr < 4; ++kr) { const int krow = rs + 4 * hh + kr; const float* bp = p.b_rpb + (h * 15 + (krow - r + 7)) * 31;
            float e[8];
#pragma unroll
            for (int ct = 0; ct < 2; ++ct)
#pragma unroll
                for (int rg = 0; rg < 4; ++rg) { const int kc = c0 + 16 * ct + 4 * g + rg; const bool ok = (kc >= cs) && (kc < cs + 16);
                    const float bias = bp[min(max(kc - qc + 15, 0), 30)]; const float v = __builtin_amdgcn_exp2f(s[kr * 2 + ct][rg] + bias * LOG2E);
                    e[ct * 4 + rg] = ok ? v : 0.f; lsum += e[ct * 4 + rg]; }
#pragma unroll
            for (int k2 = 0; k2 < 4; ++k2) pw[kr][k2] = cvtpk(e[2 * k2], e[2 * k2 + 1]); }
        lsum += swz_xor<16>(lsum); lsum = add32(lsum);
        asm volatile("s_waitcnt vmcnt(0)\n\ts_barrier" ::: "memory");
        f32x4v o[4];
#pragma unroll
        for (int dt = 0; dt < 4; ++dt) o[dt] = (f32x4v){0.f, 0.f, 0.f, 0.f};
        const ALAS unsigned char* vb = lds + (size_t)(c0 + 4 * g + (t16 >> 2)) * 128 + (t16 & 3) * 8;
#pragma unroll
        for (int kr = 0; kr < 4; ++kr) { const u32x4 pa = {pw[kr][0], pw[kr][1], pw[kr][2], pw[kr][3]}; const int ro = ((rs + 4 * hh + kr) & 7) * 8192;
#pragma unroll
            for (int dt = 0; dt < 4; ++dt) { const s16x4 lo = vtr(vb + ro + dt * 32), hv = vtr(vb + ro + 2048 + dt * 32);
                const bf16x8 vf = (bf16x8){lo[0], lo[1], lo[2], lo[3], hv[0], hv[1], hv[2], hv[3]};
                o[dt] = __builtin_amdgcn_mfma_f32_16x16x32_bf16(vf, __builtin_bit_cast(bf16x8, pa), o[dt], 0, 0, 0); } }
        ALAS float* xo = (ALAS float*)(lds + XOFF) + j * 1040;
        if (hh == 1) {
#pragma unroll
            for (int dt = 0; dt < 4; ++dt)
#pragma unroll
                for (int rg = 0; rg < 4; ++rg) xo[(dt * 4 + rg) * 64 + lane] = o[dt][rg];
            if (lane < 16) xo[1024 + lane] = lsum;
        }
        asm volatile("s_waitcnt lgkmcnt(0)\n\ts_barrier" ::: "memory");
        if (hh == 0) {
            const float li = 1.f / (lsum + xo[1024 + t16]);
            bf16_t* orow = H + (rowbase + (size_t)r * 64 + qc) * DM + 512 + h * 64 + 4 * g;
#pragma unroll
            for (int dt = 0; dt < 4; ++dt) { u32x2 w;
                w.x = cvtpk((o[dt][0] + xo[(dt * 4 + 0) * 64 + lane]) * li, (o[dt][1] + xo[(dt * 4 + 1) * 64 + lane]) * li);
                w.y = cvtpk((o[dt][2] + xo[(dt * 4 + 2) * 64 + lane]) * li, (o[dt][3] + xo[(dt * 4 + 3) * 64 + lane]) * li);
                *(u32x2*)(orow + dt * 16) = w; }
        }
        asm volatile("s_waitcnt lgkmcnt(0)\n\ts_barrier" ::: "memory");
    }
}
}


#define LAS __attribute__((address_space(3)))
#define XB_TMO      128
#define XB_XCNT(j)  (256  + 64 * (j))
#define XB_XSUB(j)  (1280 + 64 * (j))
#define XB_XGEN(j)  (2304 + 64 * (j))
#define XB_TOP      3328
#define XB_TOPGEN   3392
#define XCD_BAR_WORDS 3456
#define XB_SPIN_CAP (1u << 18)

__device__ __forceinline__ unsigned xb_ld(unsigned* p)              { return __hip_atomic_load(p, __ATOMIC_RELAXED, __HIP_MEMORY_SCOPE_AGENT); }
__device__ __forceinline__ unsigned xb_add(unsigned* p, unsigned v) { return __hip_atomic_fetch_add(p, v, __ATOMIC_RELAXED, __HIP_MEMORY_SCOPE_AGENT); }
__device__ __forceinline__ unsigned xb_xcc_id() { return (unsigned)__builtin_amdgcn_s_getreg((3 << 11) | 20) & 0xFu; }
#define XB_SPIN(cond, bar) do { unsigned _sp = 0; while (cond) { __builtin_amdgcn_s_sleep(1); \
    if ((++_sp & 255u) == 0u) { if (xb_ld(&(bar)[XB_TMO])) break; if (_sp > XB_SPIN_CAP) { atomicAdd(&(bar)[XB_TMO], 1u); break; } } } } while (0)

struct XcdBarrier {
    unsigned* bar; unsigned x;
    volatile LAS unsigned* st;
};

__device__ __forceinline__ XcdBarrier xcd_barrier_post(unsigned* bar, volatile LAS unsigned* st) {
    XcdBarrier b; b.bar = bar; b.x = xb_xcc_id(); b.st = st;
    if (threadIdx.x == 0) (void)xb_add(&bar[XB_XCNT(b.x)], 1u);
    return b;
}
__device__ __forceinline__ void xcd_barrier_complete(unsigned* bar, unsigned x, unsigned& nloc, unsigned& nx) {
    const unsigned G = gridDim.x * gridDim.y * gridDim.z;
    unsigned sum, cnt, mine, sp = 0u;
    for (;;) {
        sum = 0u; cnt = 0u; mine = 0u;
#pragma unroll
        for (unsigned j = 0; j < 16; ++j) { const unsigned c = xb_ld(&bar[XB_XCNT(j)]); sum += c; cnt += (c > 0u) ? 1u : 0u; mine = (j == x) ? c : mine; }
        if (sum == G) break;
        __builtin_amdgcn_s_sleep(1);
        if ((++sp & 255u) == 0u) { if (xb_ld(&bar[XB_TMO])) break; if (sp > XB_SPIN_CAP) { atomicAdd(&bar[XB_TMO], 1u); break; } }
    }
    nloc = mine > 0u ? mine : 1u; nx = cnt > 0u ? cnt : 1u;
}

__device__ __forceinline__ void xcd_barrier(const XcdBarrier& b) {
    asm volatile("s_waitcnt vmcnt(0)" ::: "memory");
    __syncthreads();
    if (threadIdx.x == 0) {
        unsigned* bar = b.bar;
        __builtin_amdgcn_s_waitcnt(0);
        unsigned nloc = b.st[0], nx = b.st[1];
        if (nloc == 0u) { xcd_barrier_complete(bar, b.x, nloc, nx); b.st[0] = nloc; b.st[1] = nx; }
        const unsigned old = xb_add(&bar[XB_XSUB(b.x)], 1u);
        const unsigned gen = old / nloc;
        if (old + 1u == (gen + 1u) * nloc) {
            __builtin_amdgcn_fence(__ATOMIC_RELEASE, "agent");
            asm volatile("s_waitcnt vmcnt(0)" ::: "memory");
            const unsigned og = xb_add(&bar[XB_TOP], 1u);
            const unsigned tg = og / nx;
            if (og + 1u == (tg + 1u) * nx) xb_add(&bar[XB_TOPGEN], 1u);
            else XB_SPIN(xb_ld(&bar[XB_TOPGEN]) == tg, bar);
            __builtin_amdgcn_fence(__ATOMIC_ACQUIRE, "agent");
            xb_add(&bar[XB_XGEN(b.x)], 1u);
            asm volatile("s_waitcnt vmcnt(0)" ::: "memory");
        } else {
            XB_SPIN(xb_ld(&bar[XB_XGEN(b.x)]) == gen, bar);
            __builtin_amdgcn_fence(__ATOMIC_ACQUIRE, "agent");
            asm volatile("s_waitcnt vmcnt(0)" ::: "memory");
        }
    }
    __syncthreads();
}

enum Kind { K_MODP, K_PRO, K_NORM, K_UP, K_DOWN, K_IN, K_QKN, K_ATTA, K_ATTC, K_NAT, K_OUT, K_POOL, K_PGEMM, K_DBGA, K_DBGC, K_DBGO, K_NORM0 };
struct Ph { unsigned char kind, layer, f; };
#ifndef FAST_GEMM
#define FAST_GEMM 1
#endif
#ifndef FAST_ATTA
#define FAST_ATTA 1
#endif
#ifndef FAST_NAT
#define FAST_NAT 1
#endif
#if DBG
#define NPH 28
#define MIXPH {K_QKN, 0, 0}, {K_ATTA, 0, 0}, {K_ATTC, 0, 0}, {K_DBGA, 0, 0}, {K_DBGA, 0, 1}, {K_DBGC, 0, 0}, {K_NAT, 0, 0},
#elif FAST_GEMM && FAST_ATTA && FAST_NAT
#define NPH 16
#define FUSED_NORM 1
#else
#define NPH 23
#define MIXPH {K_QKN, 0, 0}, {K_ATTA, 0, 0}, {K_ATTC, 0, 0}, {K_NAT, 0, 0},
#endif
#ifndef FUSED_NORM
#define FUSED_NORM 0
#endif
__device__ __constant__ const Ph g_prog[NPH] = {
#if FUSED_NORM
    {K_MODP, 0, 0}, {K_PRO, 0, 0},
    {K_NORM0, 0, 0}, {K_UP, 0, 0}, {K_DOWN, 0, 0},
    {K_IN, 0, 0}, {K_ATTA, 0, 0}, {K_OUT, 0, 0},
    {K_UP, 0, 1}, {K_DOWN, 0, 1},
    {K_UP, 1, 0}, {K_DOWN, 1, 0},
    {K_POOL, 1, 0}, {K_PGEMM, 1, 0},
    {K_UP, 1, 1}, {K_DOWN, 1, 1}
#else
    {K_MODP, 0, 0}, {K_PRO, 0, 0},
    {K_NORM, 0, 0}, {K_UP, 0, 0}, {K_DOWN, 0, 0},
    {K_NORM, 0, 1}, {K_IN, 0, 0}, MIXPH {K_OUT, 0, 0},
    {K_NORM, 0, 2}, {K_UP, 0, 1}, {K_DOWN, 0, 1},
    {K_NORM, 1, 0}, {K_UP, 1, 0}, {K_DOWN, 1, 0},
    {K_POOL, 1, 0}, {K_PGEMM, 1, 0},
    {K_NORM, 1, 2}, {K_UP, 1, 1}, {K_DOWN, 1, 1}
#if DBG
    , {K_DBGO, 0, 0}, {K_DBGO, 0, 1}
#endif
#endif
};

#ifndef ENMASK
#define ENMASK 0xffffu
#endif
template <class Epi> DEVI void fast_gemm(const bf16_t* A, int lda, const bf16_t* Bt, int ldb, int M, int N, int K, int acol, const Epi E, float* lds, int bid, int nb) {
    pg8::Gemm g{A, Bt, M, N, K, lda, ldb, acol}; pg8::StaticOrder S; S.init(M, N, nb, bid);
    pg8::gemm_phase<Epi, pg8::StaticOrder, true, true>((PG8_LAS unsigned char*)lds, g, S, E);
}
template <class Epi> DEVI void fast_gemm_pf(const bf16_t* A, const bf16_t* Bt, int N, const float* ss, const float* cb, const Epi E, float* lds, int bid, int nb) {
    pg8::Gemm g{A, Bt, T, N, DM, DM, DM, 0}; pg8::PrefetchOrder S; S.init(T, N, nb, bid); S.ss = ss; S.cb = cb; S.cbstride = N; S.ldsx = (unsigned)(uintptr_t)((PG8_LAS unsigned char*)lds) + pg8::STAGE_BYTES;
    pg8::gemm_phase<Epi, pg8::PrefetchOrder, true, true>((PG8_LAS unsigned char*)lds, g, S, E);
}
DEVI void run_phase(const P& p, int kind, int layer, int f, float* lds, int bid, int nb) {
    const bool first = (layer == 0 && f == 0);
    bf16_t* H = (bf16_t*)(p.ws + WS_H); bf16_t* ACT = (bf16_t*)(p.ws + WS_ACT);
    const float* mod = (const float*)(p.ws + WS_MOD);
    switch (kind) {
    case K_MODP: if constexpr ((ENMASK >> K_MODP) & 1) { ph_modp(p, lds, bid, nb); } break;
    case K_PRO: if constexpr ((ENMASK >> K_PRO) & 1) { ph_modfinal(p, bid, nb); ph_rope(p, bid, nb); ph_weights(p, lds, bid, nb); } break;
    case K_NORM: if constexpr ((ENMASK >> K_NORM) & 1) { ph_norm(p, first ? p.x : p.out, layer, f, bid, nb); } break;
#if FAST_GEMM
    case K_NORM0: ph_norm0(p, bid, nb); break;
    case K_UP: if constexpr ((ENMASK >> K_UP) & 1) { const int lf = layer * 2 + f;
        pg8::EpiSwigluF E; E.act = ACT; E.xl = (const PG8_LAS float*)((PG8_LAS unsigned char*)lds + pg8::STAGE_BYTES);
        fast_gemm_pf((lf & 1) ? (const bf16_t*)(p.ws + WS_H2) : H, (const bf16_t*)(p.ws + WS_W13T) + (size_t)lf * W13T_ELEMS, 2 * DFF,
                     (const float*)(p.ws + WS_SS) + (size_t)(lf == 0 ? 0 : lf + 1) * T, (const float*)(p.ws + WS_CB) + (size_t)lf * 4 * 2 * DFF, E, lds, bid, nb); } break;
    case K_DOWN: case K_OUT: case K_PGEMM: if constexpr ((ENMASK >> K_DOWN) & 1) {
        const bool dn = kind == K_DOWN, pl = kind == K_PGEMM;
        const bool lastp = dn && layer == 1 && f == 1;
        pg8::EpiResidF E; E.xin = p.x; E.xout = p.out; E.xinb = (const bf16_t*)(p.ws + WS_XB); E.xoutb = lastp ? nullptr : (bf16_t*)(p.ws + WS_XB); E.gate = mod + (size_t)(layer * 4 * 9 + (dn ? (f == 0 ? 2 : 8) : 5)) * 1024;
        E.half = dn ? 1 : 0; E.bias = pl ? p.pool_b : nullptr; E.scale = pl ? p.pool_scale : nullptr;
        const bool has = !(dn && layer == 1);
        const int nl = dn ? (f == 0 ? 0 : 1) : layer, nsub = dn ? (f == 0 ? 1 : 0) : 2, ssid = dn ? (f == 0 ? 1 : 3) : (pl ? 4 : 2);
        E.xt = has ? (dn ? H : (bf16_t*)(p.ws + WS_H2)) : nullptr; E.gn = p.norm_g + (nl * 3 + nsub) * 1024; E.scn = mod + (size_t)(nl * 4 * 9 + nsub * 3 + 1) * 1024; E.ss = (float*)(p.ws + WS_SS) + (size_t)ssid * T;
        const bf16_t* Bt = dn ? (const bf16_t*)(p.ws + WS_W2T) + (size_t)(layer * 2 + f) * W2T_ELEMS : pl ? (const bf16_t*)(p.ws + WS_POOLT) : (const bf16_t*)(p.ws + WS_WOUTT);
        const int K = dn ? DFF : pl ? 256 : DM;
        fast_gemm(dn ? ACT : H, dn ? DFF : DM, Bt, K, T, DM, K, pl ? 256 : 0, E, lds, bid, nb); } break;
    case K_IN: if constexpr ((ENMASK >> K_IN) & 1) { pg8::EpiQKV E; E.qkv = ACT; E.rope = (const float*)(p.ws + WS_ROPE); E.a_qk = p.a_qk_norm; E.b_qk = p.b_qk_norm;
        E.xl = (const PG8_LAS float*)((PG8_LAS unsigned char*)lds + pg8::STAGE_BYTES);
        fast_gemm_pf(H, (const bf16_t*)(p.ws + WS_WINT), INW, (const float*)(p.ws + WS_SS) + (size_t)1 * T, (const float*)(p.ws + WS_CB) + (size_t)16 * 2 * DFF, E, lds, bid, nb); } break;
    case K_QKN: break;
#else
    case K_UP: if constexpr ((ENMASK >> K_UP) & 1) { { EpiSwiglu E{ACT}; ph_gemm_naive<1>(H, DM, (const bf16_t*)(p.ws + WS_W13T) + (size_t)(layer * 2 + f) * W13T_ELEMS, DM, T, DFF, DM, E, lds, bid, nb); } } break;
    case K_DOWN: if constexpr ((ENMASK >> K_DOWN) & 1) { { EpiResid E{first ? p.x : p.out, p.out, mod, 0.5f, nullptr, nullptr, layer, f == 0 ? 2 : 8};
        ph_gemm_naive<0>(ACT, DFF, (const bf16_t*)(p.ws + WS_W2T) + (size_t)(layer * 2 + f) * W2T_ELEMS, DFF, T, DM, DFF, E, lds, bid, nb); } } break;
    case K_IN: if constexpr ((ENMASK >> K_IN) & 1) { { EpiRawQKV E{ACT}; ph_gemm_naive<0>(H, DM, (const bf16_t*)(p.ws + WS_WINT), DM, T, INW, DM, E, lds, bid, nb); } } break;
    case K_QKN: if constexpr ((ENMASK >> K_QKN) & 1) { ph_qknorm_naive(p, bid, nb); } break;
    case K_OUT: if constexpr ((ENMASK >> K_OUT) & 1) { { EpiResid E{p.out, p.out, mod, 1.0f, nullptr, nullptr, layer, 5}; ph_gemm_naive<0>(H, DM, (const bf16_t*)(p.ws + WS_WOUTT), DM, T, DM, DM, E, lds, bid, nb); } } break;
    case K_PGEMM: if constexpr ((ENMASK >> K_PGEMM) & 1) { { EpiResid E{p.out, p.out, mod, 1.0f, p.pool_b, p.pool_scale, layer, 5}; ph_gemm_naive<2>(H, DM, (const bf16_t*)(p.ws + WS_POOLT), 256, T, DM, 256, E, lds, bid, nb); } } break;
#endif
#if DBG
    case K_DBGA: att::ph_attnA(p, (bf16_t*)(p.ws + WS_OA) + (size_t)f * T * DM, (ALAS unsigned char*)lds, bid, nb); break;
    case K_DBGC: ph_dbg_cmp(p, bid, nb); break;
    case K_DBGO: if (bid == 0 && tid_opaque() == 0 && f == 0) { const float* w = (const float*)(p.ws + WS_DBGW); p.out[0] += 1000.f * w[0] + 1e6f * w[1]; } break;
#endif
#if FAST_ATTA && !DBG
    case K_ATTA: if constexpr ((ENMASK >> K_ATTA) & 1) { att::ph_attnA(p, (bf16_t*)(p.ws + WS_H), (ALAS unsigned char*)lds, bid, nb);
#if FAST_GEMM && FAST_NAT
        nat::ph_natten(p, (ALAS unsigned char*)lds, bid, nb);
#endif
        } break;
    case K_ATTC: break;
#else
    case K_ATTA: if constexpr ((ENMASK >> K_ATTA) & 1) { ph_attnA_naive(p, bid, nb); } break;
    case K_ATTC: if constexpr ((ENMASK >> K_ATTC) & 1) { ph_attnA_comb_naive(p, bid, nb); } break;
#endif
#if FAST_NAT
    case K_NAT: if constexpr ((ENMASK >> K_NAT) & 1) { nat::ph_natten(p, (ALAS unsigned char*)lds, bid, nb); } break;
#else
    case K_NAT: if constexpr ((ENMASK >> K_NAT) & 1) { ph_natten_naive(p, bid, nb); } break;
#endif
    case K_POOL: if constexpr ((ENMASK >> K_POOL) & 1) { ph_pool(p, p.out, lds, bid, nb); } break;
    default: break;
    }
}

constexpr int LDS_USED = 135168, LDS_BYTES = LDS_USED + 64;

#if !MEGA
__global__ void __launch_bounds__(NTHR) k_one(P p, int ph) {
    extern __shared__ __attribute__((aligned(16))) float lds[];
    const Ph e = g_prog[ph];
    run_phase(p, e.kind, e.layer, e.f, lds, blockIdx.x, gridDim.x);
}
#define K_MAIN k_one
#else
__global__ void __launch_bounds__(NTHR) k_mega(P p) {
    extern __shared__ __attribute__((aligned(16))) float lds[];
    cg::grid_group grid = cg::this_grid();
    volatile LAS unsigned* st = (volatile LAS unsigned*)((LAS unsigned char*)lds + LDS_USED);
    if (threadIdx.x < 2) st[threadIdx.x] = 0u;
    __syncthreads();
    { const Ph e = g_prog[0]; run_phase(p, e.kind, e.layer, e.f, lds, blockIdx.x, gridDim.x); }
    if (blockIdx.x == 0) { unsigned* bw = (unsigned*)(p.ws + WS_BAR); for (int i = threadIdx.x; i < XCD_BAR_WORDS; i += NTHR) bw[i] = 0u; }
    grid.sync();
    const XcdBarrier bar = xcd_barrier_post((unsigned*)(p.ws + WS_BAR), st);
    for (int ph = 1; ph < NPH; ++ph) {
        const Ph e = g_prog[ph];
        run_phase(p, e.kind, e.layer, e.f, lds, blockIdx.x, gridDim.x);
        if (ph + 1 < NPH) xcd_barrier(bar);
    }
}
#define K_MAIN k_mega
#endif

extern "C" void kernel_launch(void* const* d_in, const int* in_sizes, int n_in, void* d_out, int out_size, void* d_ws, size_t ws_size, hipStream_t stream) {
    static int grid = 0;
    if (grid == 0) {
        if (n_in != 17 || in_sizes[0] != T * DM || out_size != T * DM || ws_size < WS_END) { fprintf(stderr, "kernel_launch: unexpected shapes/ws (n_in %d, ws %zu)\n", n_in, ws_size); grid = -1; return; }
        int dev = 0, cus = 0, per_cu = 0;
        (void)hipGetDevice(&dev); (void)hipDeviceGetAttribute(&cus, hipDeviceAttributeMultiprocessorCount, dev);
        (void)hipFuncSetAttribute((const void*)K_MAIN, hipFuncAttributeMaxDynamicSharedMemorySize, LDS_BYTES);
        (void)hipOccupancyMaxActiveBlocksPerMultiprocessor(&per_cu, (const void*)K_MAIN, NTHR, LDS_BYTES);
        if (per_cu < 1) per_cu = 1;
        if (per_cu > 1) per_cu = 1;
        grid = cus * per_cu;
        (void)hipGetLastError();
    }
    if (grid < 0) return;
    P p{};
    const float** pp = (const float**)&p;
    for (int i = 0; i < 17; ++i) pp[i] = (const float*)d_in[i];
    p.out = (float*)d_out; p.ws = (unsigned char*)d_ws;
#if MEGA
    void* args[] = {&p};
    hipError_t e = hipLaunchCooperativeKernel((const void*)k_mega, dim3(grid), dim3(NTHR), args, LDS_BYTES, stream);
    if (e != hipSuccess) fprintf(stderr, "cooperative launch failed: %s (grid %d)\n", hipGetErrorString(e), grid);
#else
    for (int ph = 0; ph < NPH; ++ph) hipLaunchKernelGGL(k_one, dim3(grid * 4), dim3(NTHR), LDS_BYTES, stream, p, ph);
#endif
}
```

```cpp
#include <hip/hip_runtime.h>
#include <hip/hip_cooperative_groups.h>
#include <cstdio>
#include <cstdint>
namespace cg = cooperative_groups;

#ifndef DBG
#define DBG 0
#endif
#ifndef MEGA
#define MEGA 1
#endif

#define DEVI __device__ __forceinline__
typedef unsigned short bf16_t;
typedef float f32x4 __attribute__((ext_vector_type(4)));
typedef unsigned u32x4 __attribute__((ext_vector_type(4)));
typedef unsigned u32x2 __attribute__((ext_vector_type(2)));

constexpr int DM = 1024, NBATCH = 4, SEQ = 8192, T = NBATCH * SEQ, DFF = 2816, INW = 3072;
constexpr float EPS = 1e-6f, LOG2E = 1.4426950408889634f, C2 = 0.125f * LOG2E;
constexpr int NTHR = 512;

constexpr size_t MiB = 1u << 20;
constexpr size_t WS_MODP = 0, WS_MOD = 3 * MiB, WS_ROPE = 4 * MiB, WS_W13T = 6 * MiB, WS_W2T = 50 * MiB, WS_WINT = 72 * MiB, WS_WOUTT = 78 * MiB,
                 WS_POOLT = 80 * MiB, WS_H = 82 * MiB, WS_ACT = 146 * MiB, WS_OA = 338 * MiB, WS_END = 466 * MiB;
constexpr size_t WS_SS = 2359296, WS_CB = WS_MOD + 589824, WS_H2 = WS_OA;
constexpr size_t WS_XB = WS_OA + 64 * MiB;
constexpr size_t WS_BAR = 81 * MiB;
constexpr size_t WS_DBGW = WS_MOD + 512 * 1024;
constexpr size_t W13T_ELEMS = (size_t)2 * DFF * DM, W2T_ELEMS = (size_t)DM * DFF;

struct P {
    const float *x, *c, *ada_w, *ada_b, *norm_g, *ff_w13, *ff_w2, *w_in, *w_out, *a_qk_norm, *a_lambda, *a_subln, *b_qk_norm, *b_rpb, *pool_w, *pool_b, *pool_scale;
    float* out; unsigned char* ws;
};

DEVI int tid_opaque() { int t = threadIdx.x; asm volatile("" : "+v"(t)); return t; }
DEVI float bf2f(unsigned v) { return __uint_as_float(v << 16); }
DEVI float bflo(unsigned w) { return __uint_as_float(w << 16); }
DEVI float bfhi(unsigned w) { return __uint_as_float(w & 0xffff0000u); }
DEVI unsigned f2bf(float f) { unsigned u = __float_as_uint(f); return (u + 0x7fffu + ((u >> 16) & 1u)) >> 16; }
DEVI unsigned pk2(float lo, float hi) { return f2bf(lo) | (f2bf(hi) << 16); }
template <int M> DEVI float swz_xor(float v) { static_assert(M > 0 && M < 32, "ds_swizzle bit mode works inside 32-lane halves"); return __int_as_float(__builtin_amdgcn_ds_swizzle(__float_as_int(v), 0x1f | (M << 10))); }
DEVI float add32(float v) { const auto rr = __builtin_amdgcn_permlane32_swap(__float_as_uint(v), __float_as_uint(v), false, false); return __uint_as_float(rr[0]) + __uint_as_float(rr[1]); }
DEVI float max32(float v) { const auto rr = __builtin_amdgcn_permlane32_swap(__float_as_uint(v), __float_as_uint(v), false, false); return fmaxf(__uint_as_float(rr[0]), __uint_as_float(rr[1])); }
DEVI float wave_sum(float v) { v += swz_xor<1>(v); v += swz_xor<2>(v); v += swz_xor<4>(v); v += swz_xor<8>(v); v += swz_xor<16>(v); return add32(v); }
DEVI float wave_max(float v) { v = fmaxf(v, swz_xor<1>(v)); v = fmaxf(v, swz_xor<2>(v)); v = fmaxf(v, swz_xor<4>(v)); v = fmaxf(v, swz_xor<8>(v)); v = fmaxf(v, swz_xor<16>(v)); return max32(v); }
DEVI float siluf(float a) { return a / (1.f + __expf(-a)); }
DEVI const float* modptr(const P& p, int layer, int b, int m) { return (const float*)(p.ws + WS_MOD) + ((size_t)(layer * 4 + b) * 9 + m) * 1024; }

constexpr int MODP_KC = 7, MODP_KLEN = 147;
DEVI void ph_modp(const P& p, float* lds, int bid, int nb) {
    float* modp = (float*)(p.ws + WS_MODP);
#if DBG
    if (bid == 0 && tid_opaque() < 2) ((unsigned*)(p.ws + WS_DBGW))[tid_opaque()] = 0u;
#endif
    for (int i = tid_opaque(); i < 4096; i += NTHR) lds[i] = siluf(p.c[i]);
    { f32x4* ssz = (f32x4*)(p.ws + WS_SS) + T / 4; for (int i = bid * NTHR + tid_opaque(); i < 4 * T / 4; i += nb * NTHR) ssz[i] = (f32x4){0.f, 0.f, 0.f, 0.f}; }
    __syncthreads();
    const int total = 2 * MODP_KC * 9216;
    for (int i = bid * NTHR + tid_opaque(); i < total; i += nb * NTHR) {
        const int j = i % 9216, lk = i / 9216, l = lk / MODP_KC, kc = lk % MODP_KC;
        const int kb = kc * MODP_KLEN, ke = min(kb + MODP_KLEN, 1024);
        const float* w = p.ada_w + ((size_t)l * 1024 + kb) * 9216 + j;
        float a0 = 0.f, a1 = 0.f, a2 = 0.f, a3 = 0.f;
#pragma unroll 32
        for (int k = kb; k < ke; ++k) { const float wv = w[(size_t)(k - kb) * 9216];
            a0 += lds[k] * wv; a1 += lds[1024 + k] * wv; a2 += lds[2048 + k] * wv; a3 += lds[3072 + k] * wv; }
        float* o = modp + ((size_t)(kc * 2 + l) * 4) * 9216 + j;
        o[0] = a0; o[9216] = a1; o[2 * 9216] = a2; o[3 * 9216] = a3;
    }
}
DEVI void ph_modfinal(const P& p, int bid, int nb) {
    const float* modp = (const float*)(p.ws + WS_MODP); float* mod = (float*)(p.ws + WS_MOD);
    const int total = 2 * 4 * 9216;
    for (int i = bid * NTHR + tid_opaque(); i < total; i += nb * NTHR) {
        const int j = i % 9216, lb = i / 9216, l = lb >> 2, b = lb & 3;
        float s = p.ada_b[l * 9216 + j];
#pragma unroll
        for (int kc = 0; kc < MODP_KC; ++kc) s += modp[((size_t)(kc * 2 + l) * 4 + b) * 9216 + j];
        mod[i] = s;
    }
}
DEVI void ph_rope(const P& p, int bid, int nb) {
    float* rope = (float*)(p.ws + WS_ROPE);
    for (int i = bid * NTHR + tid_opaque(); i < SEQ * 32; i += nb * NTHR) {
        const int pos = i >> 5, f = i & 31;
        const float inv = powf(10000.f, -(float)(2 * f) / 64.f);
        const float ang = (float)pos * inv;
        rope[2 * i] = cosf(ang); rope[2 * i + 1] = sinf(ang);
    }
}
DEVI int map_id(int n) { return n; }
DEVI int map_w13(int n) { const int half = n >= DFF, nn = half ? n - DFF : n; return (nn >> 7) * 256 + half * 128 + (nn & 127); }
DEVI int map_win(int n) {
    const int sec = n >> 9; if (sec == 2 || sec == 5) return n;
    const int tile = n >> 8, w = n & 255, head = w >> 6, dim = w & 63; return tile * 256 + (dim >> 5) * 128 + head * 32 + (dim & 31);
}
template <int MAP> DEVI void transpose_item(const float* W, int K, int N, bf16_t* WT, float* scr, int item, int lane) {
    const int nblk = N / 32, kb = item / nblk, nbk = item % nblk, k0 = 64 * kb, n0 = 32 * nbk;
    float wv[32];
#pragma unroll
    for (int i = 0; i < 32; ++i) wv[i] = W[(size_t)(k0 + 2 * i + (lane >> 5)) * N + n0 + (lane & 31)];
#pragma unroll
    for (int i = 0; i < 32; ++i) scr[(2 * i + (lane >> 5)) * 33 + (lane & 31)] = wv[i];
    asm volatile("s_waitcnt lgkmcnt(0)" ::: "memory");
    const int c = lane & 7;
#pragma unroll
    for (int j = 0; j < 4; ++j) { const int n = (lane >> 3) + 8 * j; const float* s = scr + (8 * c) * 33 + n;
        u32x4 o; o.x = pk2(s[0 * 33], s[1 * 33]); o.y = pk2(s[2 * 33], s[3 * 33]); o.z = pk2(s[4 * 33], s[5 * 33]); o.w = pk2(s[6 * 33], s[7 * 33]);
        const int nn = n0 + n; const int row = MAP == 0 ? map_id(nn) : MAP == 1 ? map_w13(nn) : map_win(nn);
        *(u32x4*)(WT + (size_t)row * K + k0 + 8 * c) = o; }
    asm volatile("s_waitcnt lgkmcnt(0)" ::: "memory");
}
DEVI void ph_weights(const P& p, float* lds, int bid, int nb) {
    const int wave = tid_opaque() >> 6, lane = tid_opaque() & 63;
    float* scr = lds + wave * (64 * 33);
    const int gw = bid * 8 + wave, NGW = nb * 8;
    constexpr int I13 = (DM / 64) * (2 * DFF / 32), I2 = (DFF / 64) * (DM / 32), IIN = (DM / 64) * (INW / 32), IOUT = (DM / 64) * (DM / 32), IPL = (256 / 64) * (256 / 32);
    constexpr int NITEMS = 4 * I13 + 4 * I2 + IIN + IOUT + 4 * IPL;
    bf16_t* W13T = (bf16_t*)(p.ws + WS_W13T); bf16_t* W2T = (bf16_t*)(p.ws + WS_W2T);
    for (int it = gw; it < NITEMS; it += NGW) {
        int r = it;
        if (r < 4 * I13) { const int m = r / I13; transpose_item<1>(p.ff_w13 + (size_t)m * DM * 2 * DFF, DM, 2 * DFF, W13T + (size_t)m * W13T_ELEMS, scr, r % I13, lane); continue; } r -= 4 * I13;
        if (r < 4 * I2) { const int m = r / I2; transpose_item<0>(p.ff_w2 + (size_t)m * DFF * DM, DFF, DM, W2T + (size_t)m * W2T_ELEMS, scr, r % I2, lane); continue; } r -= 4 * I2;
        if (r < IIN) { transpose_item<2>(p.w_in, DM, INW, (bf16_t*)(p.ws + WS_WINT), scr, r, lane); continue; } r -= IIN;
        if (r < IOUT) { transpose_item<0>(p.w_out, DM, DM, (bf16_t*)(p.ws + WS_WOUTT), scr, r, lane); continue; } r -= IOUT;
        { const int g = r / IPL; transpose_item<0>(p.pool_w + (size_t)g * 65536, 256, 256, (bf16_t*)(p.ws + WS_POOLT) + (size_t)g * 65536, scr, r % IPL, lane); }
    }
}
DEVI void ph_norm(const P& p, const float* xin, int layer, int sub, int bid, int nb) {
    bf16_t* H = (bf16_t*)(p.ws + WS_H);
    const float* g = p.norm_g + (layer * 3 + sub) * 1024;
    const int wave = tid_opaque() >> 6, lane = tid_opaque() & 63;
    for (int row = bid * 8 + wave; row < T; row += nb * 8) {
        const int b = row / SEQ;
        const float* sh = modptr(p, layer, b, sub * 3 + 0); const float* sc = modptr(p, layer, b, sub * 3 + 1);
        const f32x4* xr = (const f32x4*)(xin + (size_t)row * DM) + lane;
        f32x4 v[4]; float ss = 0.f;
#pragma unroll
        for (int j = 0; j < 4; ++j) { v[j] = xr[64 * j]; ss += (v[j].x * v[j].x + v[j].y * v[j].y) + (v[j].z * v[j].z + v[j].w * v[j].w); }
        const float r = rsqrtf(wave_sum(ss) * (1.f / DM) + EPS);
        u32x2* o8 = (u32x2*)(H + (size_t)row * DM) + lane;
#pragma unroll
        for (int j = 0; j < 4; ++j) { const int c = 4 * lane + 256 * j;
            const f32x4 gv = *(const f32x4*)(g + c), sv = *(const f32x4*)(sc + c), hv = *(const f32x4*)(sh + c);
            const f32x4 y = (v[j] * r) * gv * (sv + 1.f) + hv;
            u32x2 w; w.x = pk2(y.x, y.y); w.y = pk2(y.z, y.w); o8[64 * j] = w; }
    }
}
DEVI void ph_norm0(const P& p, int bid, int nb) {
    bf16_t* H = (bf16_t*)(p.ws + WS_H); float* SS = (float*)(p.ws + WS_SS);
    const float* g = p.norm_g;
    const int wave = tid_opaque() >> 6, lane = tid_opaque() & 63;
    for (int row = bid * 8 + wave; row < T; row += nb * 8) {
        const int b = row / SEQ; const float* sc = modptr(p, 0, b, 1);
        const f32x4* xr = (const f32x4*)(p.x + (size_t)row * DM) + lane;
        f32x4 v[4]; float ss = 0.f;
#pragma unroll
        for (int j = 0; j < 4; ++j) { v[j] = xr[64 * j]; ss += (v[j].x * v[j].x + v[j].y * v[j].y) + (v[j].z * v[j].z + v[j].w * v[j].w); }
        ss = wave_sum(ss); if (lane == 0) SS[row] = ss;
        u32x2* o8 = (u32x2*)(H + (size_t)row * DM) + lane; u32x2* x8 = (u32x2*)((bf16_t*)(p.ws + WS_XB) + (size_t)row * DM) + lane;
#pragma unroll
        for (int j = 0; j < 4; ++j) { const int c = 4 * lane + 256 * j;
            const f32x4 y = v[j] * *(const f32x4*)(g + c) * (*(const f32x4*)(sc + c) + 1.f);
            u32x2 w; w.x = pk2(y.x, y.y); w.y = pk2(y.z, y.w); o8[64 * j] = w;
            u32x2 xw; xw.x = pk2(v[j].x, v[j].y); xw.y = pk2(v[j].z, v[j].w); x8[64 * j] = xw; }
    }
    float* CB = (float*)(p.ws + WS_CB);
    const int nrows = 4 * 2 * DFF + INW;
    for (int rw = bid * 8 + wave; rw < nrows; rw += nb * 8) {
        const bf16_t* wt; int layer, m, n, ostride; float* out;
        if (rw < 4 * 2 * DFF) { const int lf = rw / (2 * DFF); n = rw % (2 * DFF); wt = (const bf16_t*)(p.ws + WS_W13T) + (size_t)lf * W13T_ELEMS + (size_t)n * DM; layer = lf >> 1; m = (lf & 1) ? 6 : 0; out = CB + (size_t)lf * 4 * 2 * DFF + n; ostride = 2 * DFF; }
        else { n = rw - 4 * 2 * DFF; wt = (const bf16_t*)(p.ws + WS_WINT) + (size_t)n * DM; layer = 0; m = 3; out = CB + (size_t)16 * 2 * DFF + n; ostride = INW; }
        float a[4] = {0.f, 0.f, 0.f, 0.f};
#pragma unroll
        for (int j = 0; j < 2; ++j) { const int k = 8 * lane + 512 * j; const u32x4 w = *(const u32x4*)(wt + k);
            const float wf[8] = {bflo(w.x), bfhi(w.x), bflo(w.y), bfhi(w.y), bflo(w.z), bfhi(w.z), bflo(w.w), bfhi(w.w)};
#pragma unroll
            for (int b = 0; b < 4; ++b) { const float* sh = modptr(p, layer, b, m) + k; const f32x4 s0 = *(const f32x4*)sh, s1 = *(const f32x4*)(sh + 4);
                a[b] += (wf[0] * s0.x + wf[1] * s0.y) + (wf[2] * s0.z + wf[3] * s0.w) + (wf[4] * s1.x + wf[5] * s1.y) + (wf[6] * s1.z + wf[7] * s1.w); } }
#pragma unroll
        for (int b = 0; b < 4; ++b) { const float t = wave_sum(a[b]); if (lane == 0) out[(size_t)b * ostride] = t; }
    }
}
DEVI void ph_pool(const P& p, const float* xin, float* lds, int bid, int nb) {
    bf16_t* H = (bf16_t*)(p.ws + WS_H); const bf16_t* XB = (const bf16_t*)(p.ws + WS_XB);
    const float* gn = p.norm_g + (1 * 3 + 1) * 1024;
    const int tid = tid_opaque(), wave = tid >> 6, lane = tid & 63;
    float* rsq = lds; float* tile = lds + 128;
    for (int chunk = bid; chunk < T / 64; chunk += nb) {
        const int t0 = chunk * 64, b = t0 / SEQ, s0 = t0 % SEQ;
        __syncthreads();
        for (int i = wave; i < 80; i += 8) { const int s = s0 - 8 + i;
            if (s >= 0 && s < SEQ) { const u32x2* xr = (const u32x2*)(XB + ((size_t)b * SEQ + s) * DM) + lane; float ss = 0.f;
#pragma unroll
                for (int j = 0; j < 4; ++j) { const u32x2 w = xr[64 * j]; const f32x4 v = {bflo(w.x), bfhi(w.x), bflo(w.y), bfhi(w.y)}; ss += (v.x * v.x + v.y * v.y) + (v.z * v.z + v.w * v.w); }
                const float r = rsqrtf(wave_sum(ss) * (1.f / DM) + EPS); if (lane == 0) rsq[i] = r; }
            else if (lane == 0) rsq[i] = 0.f; }
        __syncthreads();
        const float* sc = modptr(p, 1, b, 4);
        for (int g = 0; g < 4; ++g) { const int hw = 1 << g;
#pragma unroll
            for (int k = 0; k < 10; ++k) { const int idx = tid + 512 * k, row = idx >> 6, c4 = idx & 63, s = s0 - 8 + row;
                f32x4 v = {0.f, 0.f, 0.f, 0.f};
                if (s >= 0 && s < SEQ) { const u32x2 w = *((const u32x2*)(XB + ((size_t)b * SEQ + s) * DM + g * 256) + c4); v = (f32x4){bflo(w.x), bfhi(w.x), bflo(w.y), bfhi(w.y)} * rsq[row]; }
                *(f32x4*)(tile + row * 256 + c4 * 4) = v; }
            __syncthreads();
            { const int c = tid & 255, i0 = (tid >> 8) * 32, cg = g * 256 + c;
              const float gg = gn[cg] * (1.f + sc[cg]);
              float S = 0.f;
              for (int k = -hw; k < hw; ++k) S += tile[(i0 + 8 + k) * 256 + c];
              for (int n = 0; n < 32; ++n) { const int idx = i0 + n + 8, sq = s0 + i0 + n; const int lo = max(sq - hw, 0), hi = min(sq + hw, SEQ);
                  const float y = gg * (S / (float)(hi - lo) - tile[idx * 256 + c]);
                  H[(size_t)(t0 + i0 + n) * DM + cg] = (bf16_t)f2bf(y);
                  S += tile[(idx + hw) * 256 + c] - tile[(idx - hw) * 256 + c]; } }
            __syncthreads();
        }
    }
}
struct EpiSwiglu { bf16_t* act; DEVI void operator()(int r, int c, float a, float b) const { act[(size_t)r * DFF + c] = (bf16_t)f2bf(siluf(a) * b); } };
struct EpiResid { const float* xin; float* xout; const float* mod; float coef; const float* bias; const float* scale; int layer, m;
    DEVI void operator()(int r, int c, float a, float) const { const int b = r / SEQ; const float g = mod[((size_t)(layer * 4 + b) * 9 + m) * 1024 + c];
        float v = a; if (bias) v = (v + bias[c]) * scale[c]; const size_t o = (size_t)r * DM + c; xout[o] = xin[o] + coef * g * v; } };
DEVI int unmap_win(int cb) { const int sec = cb >> 9; if (sec == 2 || sec == 5) return cb; const int tile = cb >> 8, w = cb & 255, bj = w >> 7, head = (w >> 5) & 3, j = w & 31; return tile * 256 + head * 64 + bj * 32 + j; }
struct EpiRawQKV { bf16_t* qkv; DEVI void operator()(int r, int c, float a, float) const { qkv[(size_t)r * INW + unmap_win(c)] = (bf16_t)f2bf(a); } };

template <int MODE, class Epi>
DEVI void ph_gemm_naive(const bf16_t* A, int lda, const bf16_t* Bt, int ldb, int M, int N, int K, const Epi& E, float* lds, int bid, int nb) {
    float* As = lds; float* Bs = lds + 32 * 132; float* Bs2 = Bs + 32 * 132;
    const int tid = tid_opaque(), ty = tid >> 5, tx = tid & 31;
    const int nN = N / 128, nM = M / 128;
    for (int tile = bid; tile < nM * nN; tile += nb) {
        const int pm = tile / nN, pn = tile % nN;
        const bf16_t* Ab = A + (size_t)pm * 128 * lda + (MODE == 2 ? (pn >> 1) * 256 : 0);
        const bf16_t* B1 = Bt + (size_t)(MODE == 1 ? pn * 256 : pn * 128) * ldb;
        const bf16_t* B2 = B1 + (size_t)128 * ldb;
        float acc[8][4], acc2[8][4];
#pragma unroll
        for (int i = 0; i < 8; ++i)
#pragma unroll
            for (int j = 0; j < 4; ++j) { acc[i][j] = 0.f; acc2[i][j] = 0.f; }
        for (int k0 = 0; k0 < K; k0 += 32) {
            __syncthreads();
            { const int row = tid >> 2, ks = (tid & 3) * 8;
              const u32x4 va = *(const u32x4*)(Ab + (size_t)row * lda + k0 + ks);
              float* d = As + ks * 132 + row;
              d[0] = bflo(va.x); d[132] = bfhi(va.x); d[2 * 132] = bflo(va.y); d[3 * 132] = bfhi(va.y); d[4 * 132] = bflo(va.z); d[5 * 132] = bfhi(va.z); d[6 * 132] = bflo(va.w); d[7 * 132] = bfhi(va.w);
              const u32x4 vb = *(const u32x4*)(B1 + (size_t)row * ldb + k0 + ks);
              d = Bs + ks * 132 + row;
              d[0] = bflo(vb.x); d[132] = bfhi(vb.x); d[2 * 132] = bflo(vb.y); d[3 * 132] = bfhi(vb.y); d[4 * 132] = bflo(vb.z); d[5 * 132] = bfhi(vb.z); d[6 * 132] = bflo(vb.w); d[7 * 132] = bfhi(vb.w);
              if (MODE == 1) { const u32x4 vc = *(const u32x4*)(B2 + (size_t)row * ldb + k0 + ks);
                  d = Bs2 + ks * 132 + row;
                  d[0] = bflo(vc.x); d[132] = bfhi(vc.x); d[2 * 132] = bflo(vc.y); d[3 * 132] = bfhi(vc.y); d[4 * 132] = bflo(vc.z); d[5 * 132] = bfhi(vc.z); d[6 * 132] = bflo(vc.w); d[7 * 132] = bfhi(vc.w); } }
            __syncthreads();
#pragma unroll 4
            for (int k = 0; k < 32; ++k) {
                const f32x4 a0 = *(const f32x4*)(As + k * 132 + ty * 8), a1 = *(const f32x4*)(As + k * 132 + ty * 8 + 4);
                const f32x4 bv = *(const f32x4*)(Bs + k * 132 + tx * 4);
                const float av[8] = {a0.x, a0.y, a0.z, a0.w, a1.x, a1.y, a1.z, a1.w};
#pragma unroll
                for (int i = 0; i < 8; ++i) { acc[i][0] += av[i] * bv.x; acc[i][1] += av[i] * bv.y; acc[i][2] += av[i] * bv.z; acc[i][3] += av[i] * bv.w; }
                if (MODE == 1) { const f32x4 cv = *(const f32x4*)(Bs2 + k * 132 + tx * 4);
#pragma unroll
                    for (int i = 0; i < 8; ++i) { acc2[i][0] += av[i] * cv.x; acc2[i][1] += av[i] * cv.y; acc2[i][2] += av[i] * cv.z; acc2[i][3] += av[i] * cv.w; } }
            }
        }
#pragma unroll
        for (int i = 0; i < 8; ++i)
#pragma unroll
            for (int j = 0; j < 4; ++j) E(pm * 128 + ty * 8 + i, pn * 128 + tx * 4 + j, acc[i][j], acc2[i][j]);
    }
}
DEVI void ph_qknorm_naive(const P& p, int bid, int nb) {
    bf16_t* QKV = (bf16_t*)(p.ws + WS_ACT); const float* rope = (const float*)(p.ws + WS_ROPE);
    for (int idx = bid * NTHR + tid_opaque(); idx < T * 32; idx += nb * NTHR) {
        const int slot = idx & 31, t = idx >> 5, pos = t % SEQ;
        const int sec4 = slot >> 3, hs = slot & 7;
        const int sec = sec4 < 2 ? sec4 : sec4 + 1;
        bf16_t* v = QKV + (size_t)t * INW + sec * 512 + hs * 64;
        const bool isA = sec4 < 2, isq = (sec4 & 1) == 0;
        const float* g = (isA ? p.a_qk_norm : p.b_qk_norm) + (isq ? 0 : 64);
        float ss = 0.f;
        for (int i = 0; i < 64; ++i) { const float a = bf2f(v[i]); ss += a * a; }
        const float r = rsqrtf(ss * (1.f / 64.f) + EPS), qs = isq ? C2 : 1.f;
        for (int i = 0; i < 32; ++i) { float y1 = bf2f(v[i]) * r * g[i], y2 = bf2f(v[i + 32]) * r * g[i + 32];
            if (isA) { const float cs = rope[(pos * 32 + i) * 2], sn = rope[(pos * 32 + i) * 2 + 1]; const float o1 = y1 * cs - y2 * sn, o2 = y1 * sn + y2 * cs; y1 = o1; y2 = o2; }
            v[i] = (bf16_t)f2bf(y1 * qs); v[i + 32] = (bf16_t)f2bf(y2 * qs); }
    }
}
DEVI void ph_attnA_naive(const P& p, int bid, int nb) {
    const bf16_t* QKV = (const bf16_t*)(p.ws + WS_ACT); float* OA = (float*)(p.ws + WS_OA);
    const int tid = tid_opaque(), qi = tid & 127, quarter = tid >> 7;
    for (int unit = bid; unit < 4 * 4 * 2 * 64; unit += nb) {
        const int qc = unit & 63, mp = (unit >> 6) & 1, h = (unit >> 7) & 3, b = unit >> 9;
        const int row = b * SEQ + qc * 128 + qi;
        float q[64];
        { const u32x4* qp = (const u32x4*)(QKV + (size_t)row * INW + h * 128 + mp * 64);
#pragma unroll
          for (int i = 0; i < 8; ++i) { const u32x4 w = qp[i]; q[8 * i] = bflo(w.x); q[8 * i + 1] = bfhi(w.x); q[8 * i + 2] = bflo(w.y); q[8 * i + 3] = bfhi(w.y); q[8 * i + 4] = bflo(w.z); q[8 * i + 5] = bfhi(w.z); q[8 * i + 6] = bflo(w.w); q[8 * i + 7] = bfhi(w.w); } }
        const bf16_t* kb = QKV + (size_t)b * SEQ * INW + 512 + h * 128 + mp * 64;
        const bf16_t* vb = QKV + (size_t)b * SEQ * INW + 1024 + h * 128 + quarter * 32;
        float m = -INFINITY, l = 0.f, o[32];
#pragma unroll
        for (int i = 0; i < 32; ++i) o[i] = 0.f;
        for (int key = 0; key < SEQ; ++key) {
            const u32x4* kp = (const u32x4*)(kb + (size_t)key * INW);
            float s = 0.f;
#pragma unroll
            for (int i = 0; i < 8; ++i) { const u32x4 w = kp[i];
                s += q[8 * i] * bflo(w.x) + q[8 * i + 1] * bfhi(w.x) + q[8 * i + 2] * bflo(w.y) + q[8 * i + 3] * bfhi(w.y) + q[8 * i + 4] * bflo(w.z) + q[8 * i + 5] * bfhi(w.z) + q[8 * i + 6] * bflo(w.w) + q[8 * i + 7] * bfhi(w.w); }
            const float mn = fmaxf(m, s), corr = exp2f(m - mn), pe = exp2f(s - mn); m = mn; l = l * corr + pe;
            const u32x4* vp = (const u32x4*)(vb + (size_t)key * INW);
#pragma unroll
            for (int i = 0; i < 4; ++i) { const u32x4 w = vp[i];
                o[8 * i] = o[8 * i] * corr + pe * bflo(w.x); o[8 * i + 1] = o[8 * i + 1] * corr + pe * bfhi(w.x); o[8 * i + 2] = o[8 * i + 2] * corr + pe * bflo(w.y); o[8 * i + 3] = o[8 * i + 3] * corr + pe * bfhi(w.y);
                o[8 * i + 4] = o[8 * i + 4] * corr + pe * bflo(w.z); o[8 * i + 5] = o[8 * i + 5] * corr + pe * bfhi(w.z); o[8 * i + 6] = o[8 * i + 6] * corr + pe * bflo(w.w); o[8 * i + 7] = o[8 * i + 7] * corr + pe * bfhi(w.w); }
        }
        const float il = 1.f / l;
        float* op = OA + ((size_t)mp * T + row) * 512 + h * 128 + quarter * 32;
#pragma unroll
        for (int i = 0; i < 32; ++i) op[i] = o[i] * il;
    }
}
DEVI float lam_value(const P& p, int lane) {
    const float* lp = p.a_lambda;
    const float s1 = wave_sum(lp[lane] * lp[64 + lane]), s2 = wave_sum(lp[128 + lane] * lp[192 + lane]);
    return __expf(s1) - __expf(s2) + 0.2f;
}
DEVI void ph_attnA_comb_naive(const P& p, int bid, int nb) {
    const float* OA = (const float*)(p.ws + WS_OA); bf16_t* H = (bf16_t*)(p.ws + WS_H);
    const int wave = tid_opaque() >> 6, lane = tid_opaque() & 63;
    const float lam = lam_value(p, lane);
    for (int it = bid * 8 + wave; it < T * 4; it += nb * 8) {
        const int h = it & 3, t = it >> 2;
        const float* o0 = OA + (size_t)t * 512 + h * 128; const float* o1 = OA + ((size_t)T + t) * 512 + h * 128;
        const float a = o0[lane] - lam * o1[lane], c = o0[lane + 64] - lam * o1[lane + 64];
        const float r = rsqrtf(wave_sum(a * a + c * c) * (1.f / 128.f) + EPS) * 0.8f;
        H[(size_t)t * DM + h * 128 + lane] = (bf16_t)f2bf(a * r * p.a_subln[lane]);
        H[(size_t)t * DM + h * 128 + 64 + lane] = (bf16_t)f2bf(c * r * p.a_subln[64 + lane]);
    }
}
DEVI void ph_natten_naive(const P& p, int bid, int nb) {
    const bf16_t* QKV = (const bf16_t*)(p.ws + WS_ACT); bf16_t* H = (bf16_t*)(p.ws + WS_H);
    for (int idx = bid * NTHR + tid_opaque(); idx < T * 16; idx += nb * NTHR) {
        const int half = idx & 1, h = (idx >> 1) & 7, t = idx >> 4, b = t / SEQ, s = t % SEQ, r = s >> 6, c = s & 63;
        const int rs = min(max(r - 4, 0), 120), cs = min(max(c - 8, 0), 48);
        float q[64], o[32];
        { const u32x4* qp = (const u32x4*)(QKV + (size_t)t * INW + 1536 + h * 64);
#pragma unroll
          for (int i = 0; i < 8; ++i) { const u32x4 w = qp[i]; q[8 * i] = bflo(w.x); q[8 * i + 1] = bfhi(w.x); q[8 * i + 2] = bflo(w.y); q[8 * i + 3] = bfhi(w.y); q[8 * i + 4] = bflo(w.z); q[8 * i + 5] = bfhi(w.z); q[8 * i + 6] = bflo(w.w); q[8 * i + 7] = bfhi(w.w); } }
#pragma unroll
        for (int i = 0; i < 32; ++i) o[i] = 0.f;
        float m = -INFINITY, l = 0.f;
        for (int kr = 0; kr < 8; ++kr)
            for (int kc = 0; kc < 16; ++kc) {
                const int krow = rs + kr, kcol = cs + kc; const size_t tk = (size_t)b * SEQ + krow * 64 + kcol;
                const u32x4* kp = (const u32x4*)(QKV + tk * INW + 2048 + h * 64);
                const u32x4* vp = (const u32x4*)(QKV + tk * INW + 2560 + h * 64 + half * 32);
                float sc = p.b_rpb[(h * 15 + (krow - r + 7)) * 31 + (kcol - c + 15)] * LOG2E;
#pragma unroll
                for (int i = 0; i < 8; ++i) { const u32x4 w = kp[i];
                    sc += q[8 * i] * bflo(w.x) + q[8 * i + 1] * bfhi(w.x) + q[8 * i + 2] * bflo(w.y) + q[8 * i + 3] * bfhi(w.y) + q[8 * i + 4] * bflo(w.z) + q[8 * i + 5] * bfhi(w.z) + q[8 * i + 6] * bflo(w.w) + q[8 * i + 7] * bfhi(w.w); }
                const float mn = fmaxf(m, sc), corr = exp2f(m - mn), pe = exp2f(sc - mn); m = mn; l = l * corr + pe;
#pragma unroll
                for (int i = 0; i < 4; ++i) { const u32x4 w = vp[i];
                    o[8 * i] = o[8 * i] * corr + pe * bflo(w.x); o[8 * i + 1] = o[8 * i + 1] * corr + pe * bfhi(w.x); o[8 * i + 2] = o[8 * i + 2] * corr + pe * bflo(w.y); o[8 * i + 3] = o[8 * i + 3] * corr + pe * bfhi(w.y);
                    o[8 * i + 4] = o[8 * i + 4] * corr + pe * bflo(w.z); o[8 * i + 5] = o[8 * i + 5] * corr + pe * bfhi(w.z); o[8 * i + 6] = o[8 * i + 6] * corr + pe * bflo(w.w); o[8 * i + 7] = o[8 * i + 7] * corr + pe * bfhi(w.w); }
            }
        const float il = 1.f / l;
        u32x4* op = (u32x4*)(H + (size_t)t * DM + 512 + h * 64 + half * 32);
#pragma unroll
        for (int i = 0; i < 4; ++i) { u32x4 w; w.x = pk2(o[8 * i] * il, o[8 * i + 1] * il); w.y = pk2(o[8 * i + 2] * il, o[8 * i + 3] * il); w.z = pk2(o[8 * i + 4] * il, o[8 * i + 5] * il); w.w = pk2(o[8 * i + 6] * il, o[8 * i + 7] * il); op[i] = w; }
    }
}

namespace pg8 {
#define PG8_LAS __attribute__((address_space(3)))
typedef unsigned short bf16_t;
typedef short bf16x8 __attribute__((ext_vector_type(8)));
typedef float f32x4 __attribute__((ext_vector_type(4)));
typedef unsigned u32x4 __attribute__((ext_vector_type(4)));
constexpr int BM = 256, BK = 64, HALF = 128, HTB = HALF * BK * 2  , STAGE_BYTES = 8 * HTB, NXCD = 8, WGM = 8;

__host__ __device__ __forceinline__ int lds_byte(int r, int c) { const int st = (r >> 4) * 2 + (c >> 5), rr = r & 15, cc = c & 31, ob = rr * 64 + cc * 2; return st * 1024 + (ob ^ (((ob >> 9) & 1) << 5)); }
__host__ __device__ __forceinline__ void stage_rc(int b, int& R, int& C) { const int st = b / 1024, sb = b % 1024, swz = sb ^ (((sb >> 9) & 1) << 5); R = (st >> 1) * 16 + swz / 64; C = (st & 1) * 32 + (swz % 64) / 2; }
__host__ __device__ __forceinline__ int perm32(int rho) { const int n = rho >> 4, i = rho & 15; return 8 * (i >> 2) + 4 * n + (i & 3); }

struct Unit { int pm, pn, par; };
struct Gemm { const bf16_t* A; const bf16_t* Bt; int M, N, K, lda, ldb, acol; };

struct StaticOrder {
    int nM, nN, nwg, G, c;
    __host__ __device__ void init(int M, int N, int G_, int c_) { nM = M / BM; nN = N / BM; nwg = nM * nN; G = G_; c = c_; }
    __host__ __device__ bool next(int i, Unit& u) const {
        const long L = (long)i * G + c; if (L >= nwg) return false;
        int wgid = (int)L; { const int q = nwg / NXCD, r = nwg % NXCD, xcd = wgid % NXCD, off = wgid / NXCD; wgid = (xcd < r ? xcd * (q + 1) : r * (q + 1) + (xcd - r) * q) + off; }
        const int nig = WGM * nN, gid = wgid / nig, fm = gid * WGM, gsz = (nM - fm) < WGM ? (nM - fm) : WGM;
        u.pm = fm + ((wgid % nig) % gsz); u.pn = (wgid % nig) / gsz; u.par = i & 1; return true;
    }
    __device__ __forceinline__ void a_ready(const Unit&) const {}
    __device__ __forceinline__ void done(const Unit&) const {}
};
__device__ __forceinline__ unsigned cvt_pk_bf16(float lo, float hi) { unsigned r; asm volatile("v_cvt_pk_bf16_f32 %0, %1, %2" : "=v"(r) : "v"(lo), "v"(hi)); return r; }
typedef float f32x2 __attribute__((ext_vector_type(2)));
template <class Epi, class Sched, bool ALIGN_EPI = false, bool SP2 = false>
__device__ __forceinline__ void gemm_phase(PG8_LAS unsigned char* lds, const Gemm g, const Sched S, const Epi E) {
    const int tid = tid_opaque(), wid = __builtin_amdgcn_readfirstlane(tid >> 6), lane = tid & 63, wr = wid >> 2, wc = wid & 3, fr = lane & 15, fq = lane >> 4;
    const int K = g.K, nt = K / BK;
    unsigned voffA[2], voffB[2];
#pragma unroll
    for (int i = 0; i < 2; ++i) { int R, C; stage_rc(tid * 16 + i * 8192, R, C); const int Rb = Epi::PERM ? ((R & ~31) + perm32(R & 31)) : R;
        voffA[i] = (unsigned)(R * g.lda + C) * 2u; voffB[i] = (unsigned)(Rb * g.ldb + C) * 2u; }
    const size_t kstep = (size_t)(BK * 2);
    const size_t hstepA = (size_t)HALF * g.lda * 2, hstepB = (size_t)HALF * g.ldb * 2;
    const size_t tstepA = 2 * hstepA, tstepB = 2 * hstepB, acolB = (size_t)g.acol * 2;
    const unsigned ldsw = (unsigned)wid * 1024u;
    const int aoff = lds_byte(wr * 64 + fr, fq * 8), boff = lds_byte(wc * 32 + fr, fq * 8);
#define PG8_SA(b, h) (((b) * 2 + (h)) * HTB)
#define PG8_SB(b, h) ((4 + (b) * 2 + (h)) * HTB)
#define PG8_STAGE(bufoff, gbase, voff) do { _Pragma("unroll") for (int _i = 0; _i < 2; ++_i) \
        __builtin_amdgcn_global_load_lds((const unsigned*)((const char*)(gbase) + (voff)[_i]), (PG8_LAS unsigned*)(lds + (bufoff) + ldsw + _i * 8192), 16, 0, 0); } while (0)
#define PG8_LDA(dst, b, h) do { _Pragma("unroll") for (int m = 0; m < 4; ++m) _Pragma("unroll") for (int k = 0; k < 2; ++k) dst[m][k] = *(const PG8_LAS bf16x8*)(lds + PG8_SA(b, h) + aoff + m * 2048 + k * 1024); } while (0)
#define PG8_LDB(dst, b, h) do { _Pragma("unroll") for (int n = 0; n < 2; ++n) _Pragma("unroll") for (int k = 0; k < 2; ++k) dst[n][k] = *(const PG8_LAS bf16x8*)(lds + PG8_SB(b, h) + boff + n * 2048 + k * 1024); } while (0)
#define PG8_MMA(ai, bj, At, Bt) do { __builtin_amdgcn_s_setprio(1); _Pragma("unroll") for (int m = 0; m < 4; ++m) _Pragma("unroll") for (int n = 0; n < 2; ++n) _Pragma("unroll") for (int k = 0; k < 2; ++k) \
        acc[ai][bj][m][n] = __builtin_amdgcn_mfma_f32_16x16x32_bf16(Bt[n][k], At[m][k], acc[ai][bj][m][n], 0, 0, 0); __builtin_amdgcn_s_setprio(0); } while (0)
#define PG8_WAIT_V(n) asm volatile("s_waitcnt vmcnt(" #n ")" ::: "memory")
#define PG8_WAIT_L(n) asm volatile("s_waitcnt lgkmcnt(" #n ")" ::: "memory")
#define PG8_BAR __builtin_amdgcn_s_barrier()
#define PG8_SCHED __builtin_amdgcn_sched_barrier(0)
    Unit cur, nxt; int ui = 0;
    if (!S.next(0, cur)) return;
    f32x4 acc[2][2][4][2];
#pragma unroll
    for (int a = 0; a < 2; ++a)
#pragma unroll
        for (int b = 0; b < 2; ++b)
#pragma unroll
            for (int m = 0; m < 4; ++m)
#pragma unroll
                for (int n = 0; n < 2; ++n) acc[a][b][m][n] = (f32x4){0.f, 0.f, 0.f, 0.f};
    bf16x8 At[4][2], B0[2][2], B1[2][2];
    const char* cA = (const char*)g.A + (size_t)cur.pm * tstepA + (size_t)cur.pn * acolB; const char* cB = (const char*)g.Bt + (size_t)cur.pn * tstepB;
    S.a_ready(cur);
    if constexpr (SP2) {
        PG8_STAGE(PG8_SB(0, 0), cB, voffB); PG8_STAGE(PG8_SB(0, 1), cB + hstepB, voffB); PG8_STAGE(PG8_SA(0, 0), cA, voffA); PG8_STAGE(PG8_SA(0, 1), cA + hstepA, voffA);
        if (wr == 1) PG8_BAR;
        PG8_WAIT_V(2); PG8_BAR;
        PG8_STAGE(PG8_SB(1, 0), cB + kstep, voffB); PG8_STAGE(PG8_SA(1, 0), cA + kstep, voffA); PG8_STAGE(PG8_SB(1, 1), cB + hstepB + kstep, voffB);
        PG8_WAIT_V(6); PG8_BAR;
    } else {
        PG8_STAGE(PG8_SB(0, 0), cB, voffB); PG8_STAGE(PG8_SA(0, 0), cA, voffA); PG8_STAGE(PG8_SB(0, 1), cB + hstepB, voffB); PG8_STAGE(PG8_SA(0, 1), cA + hstepA, voffA);
        if (wr == 1) PG8_BAR;
        PG8_WAIT_V(4); PG8_BAR;
        PG8_STAGE(PG8_SB(1, 0), cB + kstep, voffB); PG8_STAGE(PG8_SA(1, 0), cA + kstep, voffA); PG8_STAGE(PG8_SB(1, 1), cB + hstepB + kstep, voffB);
        PG8_WAIT_V(6); PG8_BAR;
    }
    for (;;) {
        const bool has_next = S.next(ui + 1, nxt);
        const char* nA = has_next ? (const char*)g.A + (size_t)nxt.pm * tstepA + (size_t)nxt.pn * acolB : cA; const char* nB = has_next ? (const char*)g.Bt + (size_t)nxt.pn * tstepB : cB;
        for (int t = 0; t < nt; t += 2) {
            const bool last = (t == nt - 2);
            const char* a1 = cA + (size_t)(t + 1) * kstep;
            const char* a2 = last ? nA : cA + (size_t)(t + 2) * kstep; const char* b2 = last ? nB : cB + (size_t)(t + 2) * kstep;
            const char* a3 = a2 + kstep; const char* b3 = b2 + kstep;
            if (last && has_next) S.a_ready(nxt);
            if constexpr (SP2) {
            PG8_LDB(B0, 0, 0); PG8_LDB(B1, 0, 1); PG8_SCHED; PG8_LDA(At, 0, 0); PG8_STAGE(PG8_SA(1, 1), a1 + hstepA, voffA);
            PG8_WAIT_V(8); PG8_WAIT_L(0); PG8_BAR; PG8_MMA(0, 0, At, B0); PG8_MMA(0, 1, At, B1); PG8_BAR; PG8_SCHED;
            PG8_LDA(At, 0, 1); PG8_STAGE(PG8_SB(0, 0), b2, voffB); PG8_STAGE(PG8_SB(0, 1), b2 + hstepB, voffB); PG8_STAGE(PG8_SA(0, 0), a2, voffA);
            PG8_WAIT_V(8); PG8_WAIT_L(0); PG8_BAR; PG8_MMA(1, 0, At, B0); PG8_MMA(1, 1, At, B1); PG8_BAR; PG8_SCHED;
            PG8_LDB(B0, 1, 0); PG8_LDB(B1, 1, 1); PG8_SCHED; PG8_LDA(At, 1, 0); PG8_STAGE(PG8_SA(0, 1), a2 + hstepA, voffA);
            PG8_WAIT_V(8); PG8_WAIT_L(0); PG8_BAR; PG8_MMA(0, 0, At, B0); PG8_MMA(0, 1, At, B1); PG8_BAR; PG8_SCHED;
            PG8_LDA(At, 1, 1); PG8_STAGE(PG8_SB(1, 0), b3, voffB); PG8_STAGE(PG8_SB(1, 1), b3 + hstepB, voffB); PG8_STAGE(PG8_SA(1, 0), a3, voffA);
            PG8_WAIT_V(8); PG8_WAIT_L(0); PG8_BAR; PG8_MMA(1, 0, At, B0); PG8_MMA(1, 1, At, B1); PG8_BAR; PG8_SCHED;
            } else {
            PG8_LDB(B0, 0, 0); PG8_SCHED; PG8_LDA(At, 0, 0); PG8_STAGE(PG8_SA(1, 1), a1 + hstepA, voffA);
            PG8_WAIT_L(8); PG8_BAR; PG8_WAIT_L(0); PG8_MMA(0, 0, At, B0); PG8_BAR; PG8_SCHED;
            PG8_LDB(B1, 0, 1); PG8_STAGE(PG8_SB(0, 0), b2, voffB);
            PG8_BAR; PG8_WAIT_L(0); PG8_MMA(0, 1, At, B1); PG8_BAR;
            PG8_LDA(At, 0, 1); PG8_STAGE(PG8_SA(0, 0), a2, voffA);
            PG8_BAR; PG8_WAIT_L(0); PG8_MMA(1, 0, At, B0); PG8_BAR; PG8_SCHED;
            PG8_STAGE(PG8_SB(0, 1), b2 + hstepB, voffB);
            PG8_WAIT_V(6); PG8_BAR; PG8_MMA(1, 1, At, B1); PG8_BAR;
            PG8_LDB(B0, 1, 0); PG8_SCHED; PG8_LDA(At, 1, 0); PG8_STAGE(PG8_SA(0, 1), a2 + hstepA, voffA);
            PG8_WAIT_L(8); PG8_BAR; PG8_WAIT_L(0); PG8_MMA(0, 0, At, B0); PG8_BAR; PG8_SCHED;
            PG8_LDB(B1, 1, 1); PG8_STAGE(PG8_SB(1, 0), b3, voffB);
            PG8_BAR; PG8_WAIT_L(0); PG8_MMA(0, 1, At, B1); PG8_BAR;
            PG8_LDA(At, 1, 1); PG8_STAGE(PG8_SA(1, 0), a3, voffA);
            PG8_BAR; PG8_WAIT_L(0); PG8_MMA(1, 0, At, B0); PG8_BAR; PG8_SCHED;
            PG8_STAGE(PG8_SB(1, 1), b3 + hstepB, voffB);
            PG8_WAIT_V(6); PG8_BAR; PG8_MMA(1, 1, At, B1); PG8_BAR;
            }
        }
        if constexpr (ALIGN_EPI) { if (wr == 0) PG8_BAR; }
        if constexpr (!Epi::AFTER_DRAIN) { E(acc, cur, wr, wc, fr, fq); S.done(cur); }
        if (!has_next) break;
#pragma unroll
        for (int a = 0; a < 2; ++a)
#pragma unroll
            for (int b = 0; b < 2; ++b)
#pragma unroll
                for (int m = 0; m < 4; ++m)
#pragma unroll
                    for (int n = 0; n < 2; ++n) acc[a][b][m][n] = (f32x4){0.f, 0.f, 0.f, 0.f};
        cur = nxt; cA = nA; cB = nB; ++ui;
        if constexpr (ALIGN_EPI) { if (wr == 1) PG8_BAR; }
    }
    PG8_WAIT_V(0);
    if constexpr (!ALIGN_EPI) { if (wr == 0) PG8_BAR; }
    PG8_BAR;
    if constexpr (Epi::AFTER_DRAIN) { E.fused(acc, cur, wr, wc, fr, fq, lds, wid, lane); S.done(cur); }
#undef PG8_SA
#undef PG8_SB
#undef PG8_STAGE
#undef PG8_LDA
#undef PG8_LDB
#undef PG8_MMA
#undef PG8_WAIT_V
#undef PG8_WAIT_L
#undef PG8_BAR
#undef PG8_SCHED
}
}

namespace pg8 {
DEVI float fast_silu(float a) { return a * __builtin_amdgcn_rcpf(1.f + __builtin_amdgcn_exp2f(-a * LOG2E)); }
DEVI u32x4 pack8(const f32x4 a, const f32x4 b) { u32x4 w; w.x = cvt_pk_bf16(a[0], a[1]); w.y = cvt_pk_bf16(a[2], a[3]); w.z = cvt_pk_bf16(b[0], b[1]); w.w = cvt_pk_bf16(b[2], b[3]); return w; }
struct EpiSwigluF { static constexpr bool PERM = true, AFTER_DRAIN = false; bf16_t* act; const PG8_LAS float* xl;
    DEVI void operator()(const f32x4 (&acc)[2][2][4][2], const Unit& u, int wr, int wc, int fr, int fq) const {
        const int row0 = u.pm * BM + wr * 64 + fr, col0 = u.pn * 128 + wc * 32 + 8 * fq;
        const PG8_LAS float* sl = xl + u.par * 512 + wr * 64 + fr; const PG8_LAS float* cp = xl + u.par * 512 + 256 + wc * 32 + 8 * fq;
        const f32x4 c00 = *(const PG8_LAS f32x4*)cp, c01 = *(const PG8_LAS f32x4*)(cp + 4), c10 = *(const PG8_LAS f32x4*)(cp + HALF), c11 = *(const PG8_LAS f32x4*)(cp + HALF + 4);
#pragma unroll
        for (int ai = 0; ai < 2; ++ai)
#pragma unroll
            for (int m = 0; m < 4; ++m) { const int row = row0 + ai * HALF + m * 16; bf16_t* rowp = act + (size_t)row * DFF + col0;
                const float r = rsqrtf(sl[ai * HALF + m * 16] * (1.f / DM) + EPS);
                const f32x4 a0 = acc[ai][0][m][0] * r + c00, a1 = acc[ai][0][m][1] * r + c01, b0 = acc[ai][1][m][0] * r + c10, b1 = acc[ai][1][m][1] * r + c11;
                f32x4 o0, o1;
#pragma unroll
                for (int i = 0; i < 4; ++i) { o0[i] = fast_silu(a0[i]) * b0[i]; o1[i] = fast_silu(a1[i]) * b1[i]; }
                *(u32x4*)rowp = pack8(o0, o1); }
    } };
struct EpiResidF { static constexpr bool PERM = false, AFTER_DRAIN = false;
    const float* xin; float* xout; const float* gate; const float* bias; const float* scale; int half;
    bf16_t* xt; const float* gn; const float* scn; float* ss;
    const bf16_t* xinb; bf16_t* xoutb;
    DEVI void operator()(const f32x4 (&acc)[2][2][4][2], const Unit& u, int wr, int wc, int fr, int fq) const {
        const int row0 = u.pm * BM + wr * 64 + fr, col0 = u.pn * BM + wc * 32 + 4 * fq, b = u.pm >> 5;
        const float* gp = gate + (size_t)b * 9 * 1024 + col0; const float coef = half ? 0.5f : 1.0f;
        float rs[2][4];
#pragma unroll
        for (int ai = 0; ai < 2; ++ai)
#pragma unroll
            for (int m = 0; m < 4; ++m) rs[ai][m] = 0.f;
#pragma unroll
        for (int bj = 0; bj < 2; ++bj) {
            u32x2 xw[2][2][4];
#pragma unroll
            for (int n = 0; n < 2; ++n) { const int co = bj * HALF + n * 16;
                if (bj == 1 ? (n == 0) : true) {
#pragma unroll
                    for (int nn = 0; nn < 2; ++nn) if (bj == 1 || nn == n) {
#pragma unroll
                        for (int ai = 0; ai < 2; ++ai)
#pragma unroll
                            for (int m = 0; m < 4; ++m) xw[nn][ai][m] = *(const u32x2*)(xinb + (size_t)(row0 + ai * HALF + m * 16) * DM + col0 + bj * HALF + nn * 16); } }
                f32x4 gv = *(const f32x4*)(gp + co) * coef, bv = {0.f, 0.f, 0.f, 0.f}, ggv = {0.f, 0.f, 0.f, 0.f};
                if (bias) { const f32x4 sv = *(const f32x4*)(scale + col0 + co); bv = *(const f32x4*)(bias + col0 + co) * sv * gv; gv = gv * sv; }
                if (xt) ggv = *(const f32x4*)(gn + col0 + co) * (*(const f32x4*)(scn + (size_t)b * 9 * 1024 + col0 + co) + 1.f);
#pragma unroll
                for (int ai = 0; ai < 2; ++ai)
#pragma unroll
                    for (int m = 0; m < 4; ++m) { const size_t off = (size_t)(row0 + ai * HALF + m * 16) * DM + col0 + co;
                        const u32x2 w0 = xw[n][ai][m];
                        const f32x4 xv = {__uint_as_float(w0.x << 16), __uint_as_float(w0.x & 0xffff0000u), __uint_as_float(w0.y << 16), __uint_as_float(w0.y & 0xffff0000u)};
                        const f32x4 xn = xv + bv + gv * acc[ai][bj][m][n];
                        if (xoutb) { u32x2 w; w.x = cvt_pk_bf16(xn[0], xn[1]); w.y = cvt_pk_bf16(xn[2], xn[3]); *(u32x2*)(xoutb + off) = w; }
                        else *(f32x4*)(xout + off) = xn;
                        if (xt) { rs[ai][m] += (xn[0] * xn[0] + xn[1] * xn[1]) + (xn[2] * xn[2] + xn[3] * xn[3]); const f32x4 y = xn * ggv;
                            u32x2 w; w.x = cvt_pk_bf16(y[0], y[1]); w.y = cvt_pk_bf16(y[2], y[3]); *(u32x2*)(xt + off) = w; } }
                if (bj == 0 || n == 1) asm volatile("" ::: "memory"); } }
        if (xt) {
#pragma unroll
            for (int ai = 0; ai < 2; ++ai)
#pragma unroll
                for (int m = 0; m < 4; ++m) { float t = rs[ai][m]; t += swz_xor<16>(t); t = add32(t);
                    if (fq == 0) unsafeAtomicAdd(ss + row0 + ai * HALF + m * 16, t); } }
    } };
struct EpiQKV { static constexpr bool PERM = true, AFTER_DRAIN = false; bf16_t* qkv; const float* rope; const float* a_qk; const float* b_qk; const PG8_LAS float* xl;
    DEVI void operator()(const f32x4 (&acc)[2][2][4][2], const Unit& u, int wr, int wc, int fr, int fq) const {
        const int sec = u.pn >> 1, row0 = u.pm * BM + wr * 64 + fr;
        const PG8_LAS float* sl = xl + u.par * 512 + wr * 64 + fr; const PG8_LAS float* cp = xl + u.par * 512 + 256 + wc * 32 + 8 * fq;
        if (sec == 2 || sec == 5) {
            const f32x4 cv[2][2] = {{*(const PG8_LAS f32x4*)cp, *(const PG8_LAS f32x4*)(cp + 4)}, {*(const PG8_LAS f32x4*)(cp + HALF), *(const PG8_LAS f32x4*)(cp + HALF + 4)}};
            const int col0 = u.pn * BM + wc * 32 + 8 * fq;
#pragma unroll
            for (int ai = 0; ai < 2; ++ai)
#pragma unroll
                for (int m = 0; m < 4; ++m) { const int row = row0 + ai * HALF + m * 16; bf16_t* rowp = qkv + (size_t)row * INW + col0;
                    const float r = rsqrtf(sl[ai * HALF + m * 16] * (1.f / DM) + EPS);
#pragma unroll
                    for (int bj = 0; bj < 2; ++bj) *(u32x4*)(rowp + bj * HALF) = pack8(acc[ai][bj][m][0] * r + cv[bj][0], acc[ai][bj][m][1] * r + cv[bj][1]); }
        } else {
            const bool isA = sec < 2, isq = (sec == 0 || sec == 3);
            const float* g = (isA ? a_qk : b_qk) + (isq ? 0 : 64) + 8 * fq;
            const f32x4 g1[2] = {*(const f32x4*)g, *(const f32x4*)(g + 4)}, g2[2] = {*(const f32x4*)(g + 32), *(const f32x4*)(g + 36)};
            const float qs = isq ? C2 : 1.f;
#pragma unroll
            for (int ai = 0; ai < 2; ++ai)
#pragma unroll
                for (int m = 0; m < 4; ++m) { const int row = row0 + ai * HALF + m * 16;
                    const float rr = rsqrtf(sl[ai * HALF + m * 16] * (1.f / DM) + EPS);
                    const f32x4 cv[2][2] = {{*(const PG8_LAS f32x4*)cp, *(const PG8_LAS f32x4*)(cp + 4)}, {*(const PG8_LAS f32x4*)(cp + HALF), *(const PG8_LAS f32x4*)(cp + HALF + 4)}};
                    f32x4 y1[2], y2[2]; float sq = 0.f;
#pragma unroll
                    for (int n = 0; n < 2; ++n) { y1[n] = acc[ai][0][m][n] * rr + cv[0][n]; y2[n] = acc[ai][1][m][n] * rr + cv[1][n];
                        sq += (y1[n][0] * y1[n][0] + y1[n][1] * y1[n][1]) + (y1[n][2] * y1[n][2] + y1[n][3] * y1[n][3]) + (y2[n][0] * y2[n][0] + y2[n][1] * y2[n][1]) + (y2[n][2] * y2[n][2] + y2[n][3] * y2[n][3]); }
                    sq += swz_xor<16>(sq); sq = add32(sq);
                    const float r = rsqrtf(sq * (1.f / 64.f) + EPS);
#pragma unroll
                    for (int n = 0; n < 2; ++n) { y1[n] = y1[n] * r * g1[n]; y2[n] = y2[n] * r * g2[n]; }
                    if (isA) { const f32x4* rp = (const f32x4*)(rope + ((size_t)(row & (SEQ - 1)) * 32 + 8 * fq) * 2);
                        const f32x4 t0 = rp[0], t1 = rp[1], t2 = rp[2], t3 = rp[3];
                        const float cs[8] = {t0[0], t0[2], t1[0], t1[2], t2[0], t2[2], t3[0], t3[2]}, sn[8] = {t0[1], t0[3], t1[1], t1[3], t2[1], t2[3], t3[1], t3[3]};
#pragma unroll
                        for (int n = 0; n < 2; ++n)
#pragma unroll
                            for (int i = 0; i < 4; ++i) { const float a = y1[n][i], b2 = y2[n][i]; y1[n][i] = a * cs[4 * n + i] - b2 * sn[4 * n + i]; y2[n][i] = a * sn[4 * n + i] + b2 * cs[4 * n + i]; } }
#pragma unroll
                    for (int n = 0; n < 2; ++n) { y1[n] = y1[n] * qs; y2[n] = y2[n] * qs; }
                    bf16_t* dst = qkv + (size_t)row * INW + u.pn * BM + wc * 64 + 8 * fq;
                    *(u32x4*)dst = pack8(y1[0], y1[1]); *(u32x4*)(dst + 32) = pack8(y2[0], y2[1]); asm volatile("" ::: "memory"); }
        }
    } };
}


namespace att {
#define ALAS __attribute__((address_space(3)))
typedef short bf16x8 __attribute__((ext_vector_type(8)));
typedef short s16x4 __attribute__((ext_vector_type(4)));
typedef short v4i16_t __attribute__((ext_vector_type(4)));
typedef float f32x16 __attribute__((ext_vector_type(16)));
constexpr int SLOT = 16384, VOFF = 3 * SLOT, NT = SEQ / 64;
DEVI int crow(int r, int hi) { return (r & 3) + 8 * (r >> 2) + 4 * hi; }
DEVI s16x4 vtr(const ALAS unsigned char* p) { return __builtin_bit_cast(s16x4, __builtin_amdgcn_ds_read_tr16_b64_v4i16((ALAS v4i16_t*)p)); }
typedef float f32x2_t __attribute__((ext_vector_type(2))); typedef __bf16 bf16x2_t __attribute__((ext_vector_type(2)));
DEVI unsigned cvtpk(float lo, float hi) { f32x2_t v = {lo, hi}; bf16x2_t b = __builtin_convertvector(v, bf16x2_t); return __builtin_bit_cast(unsigned, b); }
DEVI void glds16(const void* g, unsigned lds_dst) {
    unsigned keep; asm volatile("s_mov_b32 %0, m0\n\ts_mov_b32 m0, %2\n\ts_nop 0\n\tglobal_load_lds_dwordx4 %1, off\n\ts_mov_b32 m0, %0" : "=&s"(keep) : "v"(g), "s"(lds_dst) : "memory"); }

template <bool SH> DEVI void attnA_body(const P& p, bf16_t* H, ALAS unsigned char* lds, int bid, int nb, const float shf) {
    const int tid = tid_opaque(), lane = tid & 63, r32 = lane & 31, hi = lane >> 5;
    const int wid = __builtin_amdgcn_readfirstlane(tid >> 6), qsub = wid >> 1, mp = wid & 1;
    const bf16_t* QKV = (const bf16_t*)(p.ws + WS_ACT);
    const float lam = lam_value(p, lane);
    const int vlane = ((lane >> 4) & 1) * 32 + (lane & 3) * 8 + (4 * hi + ((lane & 15) >> 2)) * 64;
    const int ksw = (r32 >> 2) & 3, kbase = (r32 >> 4) * 4096 + mp * 2048 + (r32 & 15) * 64, kx0 = ((hi) ^ ksw) * 16, kx1 = ((2 + hi) ^ ksw) * 16;
    const unsigned lds0 = (unsigned)(uintptr_t)lds;
    for (int i = 0;; ++i) {
        const int u = i * nb + bid; if (u >= 1024) break;
        int bh, qblk;
        if (nb == 256) { bh = (bid & 7) * 2 + (i >> 1); qblk = (i & 1) * 32 + (bid >> 3); } else { bh = u >> 6; qblk = u & 63; }
        const int b = bh >> 2, h = bh & 3; const size_t rowbase = (size_t)b * SEQ; const int q0 = qblk * 128;
        bf16x8 qr[4];
        { const bf16_t* Qw = QKV + (rowbase + q0 + qsub * 32 + r32) * INW + h * 128 + mp * 64 + hi * 8;
#pragma unroll
          for (int d0 = 0; d0 < 4; ++d0) qr[d0] = *(const bf16x8*)(Qw + d0 * 16); }
        asm volatile("s_waitcnt vmcnt(0)" : "+v"(qr[0]), "+v"(qr[1]), "+v"(qr[2]), "+v"(qr[3]) :: "memory");
        const bf16_t* ksrc = QKV + (rowbase + (wid & 3) * 16 + (lane >> 2)) * INW + 512 + h * 128 + (wid >> 2) * 64 + (((lane & 3) ^ ((lane >> 4) & 3)) * 8);
        const bf16_t* vsrc = QKV + (rowbase + 16 * (wid & 3) + (lane >> 2)) * INW + 1024 + h * 128 + (wid >> 2) * 64 + (lane & 3) * 8;
        const unsigned kdst = __builtin_amdgcn_readfirstlane(lds0 + ((wid & 3) * 4 + (wid >> 2) * 2) * 1024), vdst = __builtin_amdgcn_readfirstlane(lds0 + VOFF + ((wid >> 2) * 8 + (wid & 3)) * 1024);
#define ATT_ISSUE_K(t, so) do { const size_t go_ = (size_t)(t) * 64 * INW; glds16(ksrc + go_, kdst + (so)); glds16(ksrc + go_ + 32, kdst + (so) + 1024); } while (0)
#define ATT_ISSUE_V(t, so) do { const size_t go_ = (size_t)(t) * 64 * INW; glds16(vsrc + go_, vdst + (so)); glds16(vsrc + go_ + 32, vdst + (so) + 4096); } while (0)
#define ATT_WAITBAR(n) asm volatile("s_waitcnt vmcnt(" #n ") lgkmcnt(0)\n\ts_barrier" ::: "memory")
#define ATT_SB() __builtin_amdgcn_sched_barrier(0)
#define ATT_KLOAD(so) do { const ALAS unsigned char* Ks = lds + (so) + kbase; \
        _Pragma("unroll") for (int d0 = 0; d0 < 4; ++d0) { const int xo_ = (d0 >> 1) * 1024 + ((d0 & 1) ? kx1 : kx0); kf[2 * d0] = *(const ALAS bf16x8*)(Ks + xo_); kf[2 * d0 + 1] = *(const ALAS bf16x8*)(Ks + xo_ + 8192); } } while (0)
#define ATT_QKM() do { \
        _Pragma("unroll") for (int r = 0; r < 16; ++r) { p0[r] = 0.f; p1[r] = 0.f; } \
        _Pragma("unroll") for (int d0 = 0; d0 < 4; ++d0) { \
            p0 = __builtin_amdgcn_mfma_f32_32x32x16_bf16(kf[2 * d0], qr[d0], p0, 0, 0, 0); p1 = __builtin_amdgcn_mfma_f32_32x32x16_bf16(kf[2 * d0 + 1], qr[d0], p1, 0, 0, 0); } } while (0)
#define ATT_VLOAD(buf, so, cb) do { const ALAS unsigned char* Vs = lds + VOFF + (so) + vlane + (cb) * 4096; \
        _Pragma("unroll") for (int ks = 0; ks < 4; ++ks) { buf[2 * ks] = vtr(Vs + ks * 1024); buf[2 * ks + 1] = vtr(Vs + ks * 1024 + 512); } } while (0)
#define ATT_PVG(PW, buf, cb) do { _Pragma("unroll") for (int ks = 0; ks < 4; ++ks) { \
        const bf16x8 vf = (bf16x8){buf[2 * ks][0], buf[2 * ks][1], buf[2 * ks][2], buf[2 * ks][3], buf[2 * ks + 1][0], buf[2 * ks + 1][1], buf[2 * ks + 1][2], buf[2 * ks + 1][3]}; \
        o[cb] = __builtin_amdgcn_mfma_f32_32x32x16_bf16(__builtin_bit_cast(bf16x8, PW[ks]), vf, o[cb], 0, 0, 0); } } while (0)
#define ATT_EXPG(PN, P, B, k) do { float e_[8]; _Pragma("unroll") for (int r = 0; r < 8; ++r) { e_[r] = __builtin_amdgcn_exp2f(SH ? P[(B) + r] - shf : P[(B) + r]); } \
        _Pragma("unroll") for (int r = 0; r < 8; ++r) lsum += e_[r];     \
        PN[k] = (u32x4){cvtpk(e_[0], e_[1]), cvtpk(e_[2], e_[3]), cvtpk(e_[4], e_[5]), cvtpk(e_[6], e_[7])}; } while (0)
#define ATT_STEP(PO, PN, sknext, sv, ldk) do { ATT_QKM(); ATT_VLOAD(va, sv, 0); ATT_SB(); \
        ATT_VLOAD(vb, sv, 1); ATT_PVG(PO, va, 0); ATT_EXPG(PN, p0, 0, 0); ATT_SB(); \
        ATT_VLOAD(va, sv, 2); ATT_PVG(PO, vb, 1); ATT_EXPG(PN, p0, 8, 1); ATT_SB(); \
        ATT_VLOAD(vb, sv, 3); ATT_PVG(PO, va, 2); ATT_EXPG(PN, p1, 0, 2); ATT_SB(); \
        if (ldk) ATT_KLOAD(sknext); \
        ATT_PVG(PO, vb, 3); ATT_EXPG(PN, p1, 8, 3); ATT_SB(); } while (0)
#define ATT_ROT() do { const int tmp_ = s0; s0 = s1; s1 = s2; s2 = tmp_; } while (0)
        ATT_ISSUE_K(0, 0); ATT_ISSUE_K(1, SLOT); ATT_ISSUE_V(0, 0); ATT_ISSUE_K(2, 2 * SLOT);
        f32x16 o[4], p0, p1; u32x4 pwa[4], pwb[4]; s16x4 va[8], vb[8]; bf16x8 kf[8];
#pragma unroll
        for (int cb = 0; cb < 4; ++cb)
#pragma unroll
            for (int r = 0; r < 16; ++r) o[cb][r] = 0.f;
        float lsum = 0.f;
        ATT_WAITBAR(6); ATT_KLOAD(0);
        ATT_WAITBAR(4); ATT_ISSUE_K(3, 0); ATT_ISSUE_V(1, SLOT);
        ATT_QKM(); ATT_KLOAD(SLOT); ATT_EXPG(pwa, p0, 0, 0); ATT_EXPG(pwa, p0, 8, 1); ATT_EXPG(pwa, p1, 0, 2); ATT_EXPG(pwa, p1, 8, 3);
        int s0 = SLOT, s1 = 2 * SLOT, s2 = 0;
        for (int t = 1; t < NT - 4; t += 2) {
            ATT_WAITBAR(4); ATT_ISSUE_K(t + 3, s0); ATT_ISSUE_V(t + 1, s1);
            ATT_STEP(pwa, pwb, s1, s2, true); ATT_ROT();
            ATT_WAITBAR(4); ATT_ISSUE_K(t + 4, s0); ATT_ISSUE_V(t + 2, s1);
            ATT_STEP(pwb, pwa, s1, s2, true); ATT_ROT();
        }
        ATT_WAITBAR(4); ATT_ISSUE_V(NT - 2, s1);
        ATT_STEP(pwa, pwb, s1, s2, true); ATT_ROT();
        ATT_WAITBAR(2); ATT_ISSUE_V(NT - 1, s1);
        ATT_STEP(pwb, pwa, s1, s2, true); ATT_ROT();
        ATT_WAITBAR(2);
        ATT_STEP(pwa, pwb, s1, s2, false);
        ATT_WAITBAR(0);
        ATT_VLOAD(va, s0, 0); ATT_VLOAD(vb, s0, 1); ATT_PVG(pwb, va, 0); ATT_PVG(pwb, vb, 1); ATT_VLOAD(va, s0, 2); ATT_VLOAD(vb, s0, 3); ATT_PVG(pwb, va, 2); ATT_PVG(pwb, vb, 3);
#undef ATT_ROT
#undef ATT_ISSUE_K
#undef ATT_ISSUE_V
#undef ATT_WAITBAR
#undef ATT_SB
#undef ATT_KLOAD
#undef ATT_QKM
#undef ATT_VLOAD
#undef ATT_PVG
#undef ATT_EXPG
#undef ATT_STEP
        lsum = add32(lsum);
        float linv = 1.f / lsum; if (mp == 1) linv *= lam;
#pragma unroll
        for (int r = 0; r < 16; ++r) { const float sc = __shfl(linv, crow(r, hi));
#pragma unroll
            for (int cb = 0; cb < 4; ++cb) o[cb][r] *= sc; }
        asm volatile("s_waitcnt lgkmcnt(0)\n\ts_barrier" ::: "memory");
        ALAS float* xb = (ALAS float*)lds + qsub * 4096;
        if (mp == 1) {
#pragma unroll
            for (int r = 0; r < 16; ++r)
#pragma unroll
                for (int cb = 0; cb < 4; ++cb) xb[crow(r, hi) * 128 + cb * 32 + r32] = o[cb][r];
        }
        asm volatile("s_waitcnt lgkmcnt(0)\n\ts_barrier" ::: "memory");
        if (mp == 0) {
            float gsub[4];
#pragma unroll
            for (int cb = 0; cb < 4; ++cb) gsub[cb] = p.a_subln[cb * 32 + r32] * 0.8f;
#pragma unroll
            for (int r = 0; r < 16; ++r) { float ss = 0.f;
#pragma unroll
                for (int cb = 0; cb < 4; ++cb) { o[cb][r] -= xb[crow(r, hi) * 128 + cb * 32 + r32]; ss += o[cb][r] * o[cb][r]; }
                ss += swz_xor<1>(ss); ss += swz_xor<2>(ss); ss += swz_xor<4>(ss); ss += swz_xor<8>(ss); ss += swz_xor<16>(ss);
                const float rn = rsqrtf(ss * (1.f / 128.f) + EPS);
                bf16_t* orow = H + (rowbase + q0 + qsub * 32 + crow(r, hi)) * DM + h * 128 + r32;
#pragma unroll
                for (int cb = 0; cb < 4; ++cb) orow[cb * 32] = (bf16_t)f2bf(o[cb][r] * rn * gsub[cb]); }
        }
        asm volatile("s_waitcnt lgkmcnt(0)\n\ts_barrier" ::: "memory");
    }
}
DEVI void ph_attnA(const P& p, bf16_t* H, ALAS unsigned char* lds, int bid, int nb) {
    const int lane = tid_opaque() & 63;
    float gq = fabsf(p.a_qk_norm[lane]), gk = fabsf(p.a_qk_norm[64 + lane]);
    gq = wave_max(gq); gk = wave_max(gk);
    const float shf = __uint_as_float(__builtin_amdgcn_readfirstlane(__float_as_uint(fmaxf(8.f * LOG2E * gq * gk - 64.f, 0.f))));
    if (shf != 0.f) attnA_body<true>(p, H, lds, bid, nb, shf); else attnA_body<false>(p, H, lds, bid, nb, 0.f);
}
}


#ifndef DBG
#define DBG 1
#endif
DEVI void ph_dbg_cmp(const P& p, int bid, int nb) {
    const bf16_t* H = (const bf16_t*)(p.ws + WS_H); const bf16_t* H2 = (const bf16_t*)(p.ws + WS_OA); const bf16_t* H3 = H2 + (size_t)T * DM;
    float d0 = 0.f, d1 = 0.f;
    for (size_t i = (size_t)bid * NTHR + tid_opaque(); i < (size_t)T * 512; i += (size_t)nb * NTHR) { const size_t t = i >> 9, c = i & 511, o = t * DM + c;
        const float a = bf2f(H[o]), b = bf2f(H2[o]), c3 = bf2f(H3[o]); float e0 = fabsf(a - b), e1 = fabsf(b - c3);
        if (!(e0 == e0)) e0 = 1e6f; if (!(e1 == e1)) e1 = 1e6f;
        d0 = fmaxf(d0, e0); d1 = fmaxf(d1, e1); }
    d0 = wave_max(d0); d1 = wave_max(d1);
    if ((tid_opaque() & 63) == 0) { unsigned* w = (unsigned*)(p.ws + WS_DBGW); atomicMax(w, __float_as_uint(d0)); atomicMax(w + 1, __float_as_uint(d1)); }
}


namespace pg8 {
struct PrefetchOrder : StaticOrder {
    const float* ss; const float* cb; int cbstride; unsigned ldsx;
    DEVI void a_ready(const Unit& u) const {
        const int tid_ = tid_opaque(), wid = __builtin_amdgcn_readfirstlane(tid_ >> 6), lane = tid_ & 63;
        if (wid == 0) att::glds16(ss + (size_t)u.pm * BM + lane * 4, ldsx + u.par * 2048);
        else if (wid == 1) att::glds16(cb + (size_t)(u.pm >> 5) * cbstride + u.pn * BM + lane * 4, ldsx + u.par * 2048 + 1024);
    }
};
}

namespace nat {
using att::bf16x8; using att::s16x4; using att::vtr; using att::cvtpk; using att::glds16;
typedef float f32x4v __attribute__((ext_vector_type(4)));
constexpr int XOFF = 65536;
DEVI void ph_natten(const P& p, ALAS unsigned char* lds, int bid, int nb) {
    const int tid = tid_opaque(), lane = tid & 63, t16 = lane & 15, g = lane >> 4;
    const int wid = __builtin_amdgcn_readfirstlane(tid >> 6), j = wid & 3, hh = wid >> 2;
    const bf16_t* QKV = (const bf16_t*)(p.ws + WS_ACT); bf16_t* H = (bf16_t*)(p.ws + WS_H);
    const unsigned lds0 = (unsigned)(uintptr_t)lds;
    const int c0 = (j == 0) ? 0 : (j == 1) ? 8 : (j == 2) ? 24 : 32;
    const int qc = 16 * j + t16, cs = min(max(qc - 8, 0), 48);
    const int nunits = NBATCH * 8 * 128, per = (nunits + nb - 1) / nb;
    int cur_bh = -1, cur_rs = -100;
    for (int i = 0; i < per; ++i) {
        const int u = bid * per + i; if (u >= nunits) break;
        const int bh = u >> 7, r = u & 127, b = bh >> 3, h = bh & 7, rs = min(max(r - 4, 0), 120);
        const size_t rowbase = (size_t)b * SEQ;
        { const bf16_t* vrow0 = QKV + (rowbase + (lane >> 3)) * INW + 2560 + h * 64 + (lane & 7) * 8;
          if (bh != cur_bh || rs != cur_rs + 1) {
              if (bh != cur_bh || rs != cur_rs) {
                  const int krow = rs + wid; const unsigned vdst = __builtin_amdgcn_readfirstlane(lds0 + (krow & 7) * 8192);
#pragma unroll
                  for (int pc = 0; pc < 8; ++pc) glds16(vrow0 + (size_t)(krow * 64 + pc * 8) * INW, vdst + pc * 1024); }
          } else { const int krow = rs + 7; glds16(vrow0 + (size_t)(krow * 64 + wid * 8) * INW, __builtin_amdgcn_readfirstlane(lds0 + (krow & 7) * 8192 + wid * 1024)); }
          cur_bh = bh; cur_rs = rs; }
        bf16x8 qf[2];
        { const bf16_t* qp = QKV + (rowbase + (size_t)r * 64 + qc) * INW + 1536 + h * 64 + 8 * g; qf[0] = *(const bf16x8*)qp; qf[1] = *(const bf16x8*)(qp + 32); }
        f32x4v s[8];
        const bf16_t* kbase = QKV + (rowbase + (size_t)(rs + 4 * hh) * 64 + c0 + t16) * INW + 2048 + h * 64 + 8 * g;
#pragma unroll
        for (int tl = 0; tl < 8; ++tl) { const bf16_t* kp = kbase + (size_t)((tl >> 1) * 64 + (tl & 1) * 16) * INW;
            const bf16x8 k0 = *(const bf16x8*)kp, k1 = *(const bf16x8*)(kp + 32);
            f32x4v a = {0.f, 0.f, 0.f, 0.f};
            a = __builtin_amdgcn_mfma_f32_16x16x32_bf16(k0, qf[0], a, 0, 0, 0); a = __builtin_amdgcn_mfma_f32_16x16x32_bf16(k1, qf[1], a, 0, 0, 0); s[tl] = a; }
        float lsum = 0.f; unsigned pw[4][4];
#pragma unroll
        for (int kr = 0; kr < 4; ++kr) { const int krow = rs + 4 * hh + kr; const float* bp = p.b_rpb + (h * 15 + (krow - r + 7)) * 31;
            float e[8];
#pragma unroll
            for (int ct = 0; ct < 2; ++ct)
#pragma unroll
                for (int rg = 0; rg < 4; ++rg) { const int kc = c0 + 16 * ct + 4 * g + rg; const bool ok = (kc >= cs) && (kc < cs + 16);
                    const float bias = bp[min(max(kc - qc + 15, 0), 30)]; const float v = __builtin_amdgcn_exp2f(s[kr * 2 + ct][rg] + bias * LOG2E);
                    e[ct * 4 + rg] = ok ? v : 0.f; lsum += e[ct * 4 + rg]; }
#pragma unroll
            for (int k2 = 0; k2 < 4; ++k2) pw[kr][k2] = cvtpk(e[2 * k2], e[2 * k2 + 1]); }
        lsum += swz_xor<16>(lsum); lsum = add32(lsum);
        asm volatile("s_waitcnt vmcnt(0)\n\ts_barrier" ::: "memory");
        f32x4v o[4];
#pragma unroll
        for (int dt = 0; dt < 4; ++dt) o[dt] = (f32x4v){0.f, 0.f, 0.f, 0.f};
        const ALAS unsigned char* vb = lds + (size_t)(c0 + 4 * g + (t16 >> 2)) * 128 + (t16 & 3) * 8;
#pragma unroll
        for (int kr = 0; kr < 4; ++kr) { const u32x4 pa = {pw[kr][0], pw[kr][1], pw[kr][2], pw[kr][3]}; const int ro = ((rs + 4 * hh + kr) & 7) * 8192;
#pragma unroll
            for (int dt = 0; dt < 4; ++dt) { const s16x4 lo = vtr(vb + ro + dt * 32), hv = vtr(vb + ro + 2048 + dt * 32);
                const bf16x8 vf = (bf16x8){lo[0], lo[1], lo[2], lo[3], hv[0], hv[1], hv[2], hv[3]};
                o[dt] = __builtin_amdgcn_mfma_f32_16x16x32_bf16(__builtin_bit_cast(bf16x8, pa), vf, o[dt], 0, 0, 0); } }
        ALAS float* xo = (ALAS float*)(lds + XOFF) + j * 1040;
        if (hh == 1) {
#pragma unroll
            for (int dt = 0; dt < 4; ++dt)
#pragma unroll
                for (int rg = 0; rg < 4; ++rg) xo[(4 * g + rg) * 64 + dt * 16 + t16] = o[dt][rg];
            if (lane < 16) xo[1024 + lane] = lsum;
        }
        asm volatile("s_waitcnt lgkmcnt(0)\n\ts_barrier" ::: "memory");
        if (hh == 0) {
            const float lt = lsum + xo[1024 + t16];
            const float li = 1.f / lt;
            bf16_t* orow = H + (rowbase + (size_t)r * 64 + 16 * j) * DM + 512 + h * 64 + t16;
#pragma unroll
            for (int rg = 0; rg < 4; ++rg) { const float sc = __shfl(li, 4 * g + rg);
#pragma unroll
                for (int dt = 0; dt < 4; ++dt) orow[(size_t)(4 * g + rg) * DM + dt * 16] = (bf16_t)f2bf((o[dt][rg] + xo[(4 * g + rg) * 64 + dt * 16 + t16]) * sc); }
        }
        asm volatile("s_waitcnt lgkmcnt(0)\n\ts_barrier" ::: "memory");
    }
}
}


#define LAS __attribute__((address_space(3)))
#define XB_TMO      128
#define XB_XCNT(j)  (256  + 64 * (j))
#define XB_XSUB(j)  (1280 + 64 * (j))
#define XB_XGEN(j)  (2304 + 64 * (j))
#define XB_TOP      3328
#define XB_TOPGEN   3392
#define XCD_BAR_WORDS 3456
#define XB_SPIN_CAP (1u << 18)

__device__ __forceinline__ unsigned xb_ld(unsigned* p)              { return __hip_atomic_load(p, __ATOMIC_RELAXED, __HIP_MEMORY_SCOPE_AGENT); }
__device__ __forceinline__ unsigned xb_add(unsigned* p, unsigned v) { return __hip_atomic_fetch_add(p, v, __ATOMIC_RELAXED, __HIP_MEMORY_SCOPE_AGENT); }
__device__ __forceinline__ unsigned xb_xcc_id() { return (unsigned)__builtin_amdgcn_s_getreg((3 << 11) | 20) & 0xFu; }
#define XB_SPIN(cond, bar) do { unsigned _sp = 0; while (cond) { __builtin_amdgcn_s_sleep(1); \
    if ((++_sp & 255u) == 0u) { if (xb_ld(&(bar)[XB_TMO])) break; if (_sp > XB_SPIN_CAP) { atomicAdd(&(bar)[XB_TMO], 1u); break; } } } } while (0)

struct XcdBarrier {
    unsigned* bar; unsigned x;
    volatile LAS unsigned* st;
};

__device__ __forceinline__ XcdBarrier xcd_barrier_post(unsigned* bar, volatile LAS unsigned* st) {
    XcdBarrier b; b.bar = bar; b.x = xb_xcc_id(); b.st = st;
    if (threadIdx.x == 0) (void)xb_add(&bar[XB_XCNT(b.x)], 1u);
    return b;
}
__device__ __forceinline__ void xcd_barrier_complete(unsigned* bar, unsigned x, unsigned& nloc, unsigned& nx) {
    const unsigned G = gridDim.x * gridDim.y * gridDim.z;
    unsigned sum, cnt, mine, sp = 0u;
    for (;;) {
        sum = 0u; cnt = 0u; mine = 0u;
#pragma unroll
        for (unsigned j = 0; j < 16; ++j) { const unsigned c = xb_ld(&bar[XB_XCNT(j)]); sum += c; cnt += (c > 0u) ? 1u : 0u; mine = (j == x) ? c : mine; }
        if (sum == G) break;
        __builtin_amdgcn_s_sleep(1);
        if ((++sp & 255u) == 0u) { if (xb_ld(&bar[XB_TMO])) break; if (sp > XB_SPIN_CAP) { atomicAdd(&bar[XB_TMO], 1u); break; } }
    }
    nloc = mine > 0u ? mine : 1u; nx = cnt > 0u ? cnt : 1u;
}

__device__ __forceinline__ void xcd_barrier(const XcdBarrier& b) {
    asm volatile("s_waitcnt vmcnt(0)" ::: "memory");
    __syncthreads();
    if (threadIdx.x == 0) {
        unsigned* bar = b.bar;
        __builtin_amdgcn_s_waitcnt(0);
        unsigned nloc = b.st[0], nx = b.st[1];
        if (nloc == 0u) { xcd_barrier_complete(bar, b.x, nloc, nx); b.st[0] = nloc; b.st[1] = nx; }
        const unsigned old = xb_add(&bar[XB_XSUB(b.x)], 1u);
        const unsigned gen = old / nloc;
        if (old + 1u == (gen + 1u) * nloc) {
            __builtin_amdgcn_fence(__ATOMIC_RELEASE, "agent");
            asm volatile("s_waitcnt vmcnt(0)" ::: "memory");
            const unsigned og = xb_add(&bar[XB_TOP], 1u);
            const unsigned tg = og / nx;
            if (og + 1u == (tg + 1u) * nx) xb_add(&bar[XB_TOPGEN], 1u);
            else XB_SPIN(xb_ld(&bar[XB_TOPGEN]) == tg, bar);
            __builtin_amdgcn_fence(__ATOMIC_ACQUIRE, "agent");
            xb_add(&bar[XB_XGEN(b.x)], 1u);
            asm volatile("s_waitcnt vmcnt(0)" ::: "memory");
        } else {
            XB_SPIN(xb_ld(&bar[XB_XGEN(b.x)]) == gen, bar);
            __builtin_amdgcn_fence(__ATOMIC_ACQUIRE, "agent");
            asm volatile("s_waitcnt vmcnt(0)" ::: "memory");
        }
    }
    __syncthreads();
}

enum Kind { K_MODP, K_PRO, K_NORM, K_UP, K_DOWN, K_IN, K_QKN, K_ATTA, K_ATTC, K_NAT, K_OUT, K_POOL, K_PGEMM, K_DBGA, K_DBGC, K_DBGO, K_NORM0 };
struct Ph { unsigned char kind, layer, f; };
#ifndef FAST_GEMM
#define FAST_GEMM 1
#endif
#ifndef FAST_ATTA
#define FAST_ATTA 1
#endif
#ifndef FAST_NAT
#define FAST_NAT 1
#endif
#if DBG
#define NPH 28
#define MIXPH {K_QKN, 0, 0}, {K_ATTA, 0, 0}, {K_ATTC, 0, 0}, {K_DBGA, 0, 0}, {K_DBGA, 0, 1}, {K_DBGC, 0, 0}, {K_NAT, 0, 0},
#elif FAST_GEMM && FAST_ATTA && FAST_NAT
#define NPH 16
#define FUSED_NORM 1
#else
#define NPH 23
#define MIXPH {K_QKN, 0, 0}, {K_ATTA, 0, 0}, {K_ATTC, 0, 0}, {K_NAT, 0, 0},
#endif
#ifndef FUSED_NORM
#define FUSED_NORM 0
#endif
__device__ __constant__ const Ph g_prog[NPH] = {
#if FUSED_NORM
    {K_MODP, 0, 0}, {K_PRO, 0, 0},
    {K_NORM0, 0, 0}, {K_UP, 0, 0}, {K_DOWN, 0, 0},
    {K_IN, 0, 0}, {K_ATTA, 0, 0}, {K_OUT, 0, 0},
    {K_UP, 0, 1}, {K_DOWN, 0, 1},
    {K_UP, 1, 0}, {K_DOWN, 1, 0},
    {K_POOL, 1, 0}, {K_PGEMM, 1, 0},
    {K_UP, 1, 1}, {K_DOWN, 1, 1}
#else
    {K_MODP, 0, 0}, {K_PRO, 0, 0},
    {K_NORM, 0, 0}, {K_UP, 0, 0}, {K_DOWN, 0, 0},
    {K_NORM, 0, 1}, {K_IN, 0, 0}, MIXPH {K_OUT, 0, 0},
    {K_NORM, 0, 2}, {K_UP, 0, 1}, {K_DOWN, 0, 1},
    {K_NORM, 1, 0}, {K_UP, 1, 0}, {K_DOWN, 1, 0},
    {K_POOL, 1, 0}, {K_PGEMM, 1, 0},
    {K_NORM, 1, 2}, {K_UP, 1, 1}, {K_DOWN, 1, 1}
#if DBG
    , {K_DBGO, 0, 0}, {K_DBGO, 0, 1}
#endif
#endif
};

#ifndef ENMASK
#define ENMASK 0xffffu
#endif
template <class Epi> DEVI void fast_gemm(const bf16_t* A, int lda, const bf16_t* Bt, int ldb, int M, int N, int K, int acol, const Epi E, float* lds, int bid, int nb) {
    pg8::Gemm g{A, Bt, M, N, K, lda, ldb, acol}; pg8::StaticOrder S; S.init(M, N, nb, bid);
    pg8::gemm_phase<Epi, pg8::StaticOrder, true, true>((PG8_LAS unsigned char*)lds, g, S, E);
}
template <class Epi> DEVI void fast_gemm_pf(const bf16_t* A, const bf16_t* Bt, int N, const float* ss, const float* cb, const Epi E, float* lds, int bid, int nb) {
    pg8::Gemm g{A, Bt, T, N, DM, DM, DM, 0}; pg8::PrefetchOrder S; S.init(T, N, nb, bid); S.ss = ss; S.cb = cb; S.cbstride = N; S.ldsx = (unsigned)(uintptr_t)((PG8_LAS unsigned char*)lds) + pg8::STAGE_BYTES;
    pg8::gemm_phase<Epi, pg8::PrefetchOrder, true, true>((PG8_LAS unsigned char*)lds, g, S, E);
}
DEVI void run_phase(const P& p, int kind, int layer, int f, float* lds, int bid, int nb) {
    const bool first = (layer == 0 && f == 0);
    bf16_t* H = (bf16_t*)(p.ws + WS_H); bf16_t* ACT = (bf16_t*)(p.ws + WS_ACT);
    const float* mod = (const float*)(p.ws + WS_MOD);
    switch (kind) {
    case K_MODP: if constexpr ((ENMASK >> K_MODP) & 1) { ph_modp(p, lds, bid, nb); } break;
    case K_PRO: if constexpr ((ENMASK >> K_PRO) & 1) { ph_modfinal(p, bid, nb); ph_rope(p, bid, nb); ph_weights(p, lds, bid, nb); } break;
    case K_NORM: if constexpr ((ENMASK >> K_NORM) & 1) { ph_norm(p, first ? p.x : p.out, layer, f, bid, nb); } break;
#if FAST_GEMM
    case K_NORM0: ph_norm0(p, bid, nb); break;
    case K_UP: if constexpr ((ENMASK >> K_UP) & 1) { const int lf = layer * 2 + f;
        pg8::EpiSwigluF E; E.act = ACT; E.xl = (const PG8_LAS float*)((PG8_LAS unsigned char*)lds + pg8::STAGE_BYTES);
        fast_gemm_pf((lf & 1) ? (const bf16_t*)(p.ws + WS_H2) : H, (const bf16_t*)(p.ws + WS_W13T) + (size_t)lf * W13T_ELEMS, 2 * DFF,
                     (const float*)(p.ws + WS_SS) + (size_t)(lf == 0 ? 0 : lf + 1) * T, (const float*)(p.ws + WS_CB) + (size_t)lf * 4 * 2 * DFF, E, lds, bid, nb); } break;
    case K_DOWN: case K_OUT: case K_PGEMM: if constexpr ((ENMASK >> K_DOWN) & 1) {
        const bool dn = kind == K_DOWN, pl = kind == K_PGEMM;
        const bool lastp = dn && layer == 1 && f == 1;
        pg8::EpiResidF E; E.xin = p.x; E.xout = p.out; E.xinb = (const bf16_t*)(p.ws + WS_XB); E.xoutb = lastp ? nullptr : (bf16_t*)(p.ws + WS_XB); E.gate = mod + (size_t)(layer * 4 * 9 + (dn ? (f == 0 ? 2 : 8) : 5)) * 1024;
        E.half = dn ? 1 : 0; E.bias = pl ? p.pool_b : nullptr; E.scale = pl ? p.pool_scale : nullptr;
        const bool has = !(dn && layer == 1);
        const int nl = dn ? (f == 0 ? 0 : 1) : layer, nsub = dn ? (f == 0 ? 1 : 0) : 2, ssid = dn ? (f == 0 ? 1 : 3) : (pl ? 4 : 2);
        E.xt = has ? (dn ? H : (bf16_t*)(p.ws + WS_H2)) : nullptr; E.gn = p.norm_g + (nl * 3 + nsub) * 1024; E.scn = mod + (size_t)(nl * 4 * 9 + nsub * 3 + 1) * 1024; E.ss = (float*)(p.ws + WS_SS) + (size_t)ssid * T;
        const bf16_t* Bt = dn ? (const bf16_t*)(p.ws + WS_W2T) + (size_t)(layer * 2 + f) * W2T_ELEMS : pl ? (const bf16_t*)(p.ws + WS_POOLT) : (const bf16_t*)(p.ws + WS_WOUTT);
        const int K = dn ? DFF : pl ? 256 : DM;
        fast_gemm(dn ? ACT : H, dn ? DFF : DM, Bt, K, T, DM, K, pl ? 256 : 0, E, lds, bid, nb); } break;
    case K_IN: if constexpr ((ENMASK >> K_IN) & 1) { pg8::EpiQKV E; E.qkv = ACT; E.rope = (const float*)(p.ws + WS_ROPE); E.a_qk = p.a_qk_norm; E.b_qk = p.b_qk_norm;
        E.xl = (const PG8_LAS float*)((PG8_LAS unsigned char*)lds + pg8::STAGE_BYTES);
        fast_gemm_pf(H, (const bf16_t*)(p.ws + WS_WINT), INW, (const float*)(p.ws + WS_SS) + (size_t)1 * T, (const float*)(p.ws + WS_CB) + (size_t)16 * 2 * DFF, E, lds, bid, nb); } break;
    case K_QKN: break;
#else
    case K_UP: if constexpr ((ENMASK >> K_UP) & 1) { { EpiSwiglu E{ACT}; ph_gemm_naive<1>(H, DM, (const bf16_t*)(p.ws + WS_W13T) + (size_t)(layer * 2 + f) * W13T_ELEMS, DM, T, DFF, DM, E, lds, bid, nb); } } break;
    case K_DOWN: if constexpr ((ENMASK >> K_DOWN) & 1) { { EpiResid E{first ? p.x : p.out, p.out, mod, 0.5f, nullptr, nullptr, layer, f == 0 ? 2 : 8};
        ph_gemm_naive<0>(ACT, DFF, (const bf16_t*)(p.ws + WS_W2T) + (size_t)(layer * 2 + f) * W2T_ELEMS, DFF, T, DM, DFF, E, lds, bid, nb); } } break;
    case K_IN: if constexpr ((ENMASK >> K_IN) & 1) { { EpiRawQKV E{ACT}; ph_gemm_naive<0>(H, DM, (const bf16_t*)(p.ws + WS_WINT), DM, T, INW, DM, E, lds, bid, nb); } } break;
    case K_QKN: if constexpr ((ENMASK >> K_QKN) & 1) { ph_qknorm_naive(p, bid, nb); } break;
    case K_OUT: if constexpr ((ENMASK >> K_OUT) & 1) { { EpiResid E{p.out, p.out, mod, 1.0f, nullptr, nullptr, layer, 5}; ph_gemm_naive<0>(H, DM, (const bf16_t*)(p.ws + WS_WOUTT), DM, T, DM, DM, E, lds, bid, nb); } } break;
    case K_PGEMM: if constexpr ((ENMASK >> K_PGEMM) & 1) { { EpiResid E{p.out, p.out, mod, 1.0f, p.pool_b, p.pool_scale, layer, 5}; ph_gemm_naive<2>(H, DM, (const bf16_t*)(p.ws + WS_POOLT), 256, T, DM, 256, E, lds, bid, nb); } } break;
#endif
#if DBG
    case K_DBGA: att::ph_attnA(p, (bf16_t*)(p.ws + WS_OA) + (size_t)f * T * DM, (ALAS unsigned char*)lds, bid, nb); break;
    case K_DBGC: ph_dbg_cmp(p, bid, nb); break;
    case K_DBGO: if (bid == 0 && tid_opaque() == 0 && f == 0) { const float* w = (const float*)(p.ws + WS_DBGW); p.out[0] += 1000.f * w[0] + 1e6f * w[1]; } break;
#endif
#if FAST_ATTA && !DBG
    case K_ATTA: if constexpr ((ENMASK >> K_ATTA) & 1) { att::ph_attnA(p, (bf16_t*)(p.ws + WS_H), (ALAS unsigned char*)lds, bid, nb);
#if FAST_GEMM && FAST_NAT
        nat::ph_natten(p, (ALAS unsigned char*)lds, bid, nb);
#endif
        } break;
    case K_ATTC: break;
#else
    case K_ATTA: if constexpr ((ENMASK >> K_ATTA) & 1) { ph_attnA_naive(p, bid, nb); } break;
    case K_ATTC: if constexpr ((ENMASK >> K_ATTC) & 1) { ph_attnA_comb_naive(p, bid, nb); } break;
#endif
#if FAST_NAT
    case K_NAT: if constexpr ((ENMASK >> K_NAT) & 1) { nat::ph_natten(p, (ALAS unsigned char*)lds, bid, nb); } break;
#else
    case K_NAT: if constexpr ((ENMASK >> K_NAT) & 1) { ph_natten_naive(p, bid, nb); } break;
#endif
    case K_POOL: if constexpr ((ENMASK >> K_POOL) & 1) { ph_pool(p, p.out, lds, bid, nb); } break;
    default: break;
    }
}

constexpr int LDS_USED = 135168, LDS_BYTES = LDS_USED + 64;

#if !MEGA
__global__ void __launch_bounds__(NTHR) k_one(P p, int ph) {
    extern __shared__ __attribute__((aligned(16))) float lds[];
    const Ph e = g_prog[ph];
    run_phase(p, e.kind, e.layer, e.f, lds, blockIdx.x, gridDim.x);
}
#define K_MAIN k_one
#else
__global__ void __launch_bounds__(NTHR) k_mega(P p) {
    extern __shared__ __attribute__((aligned(16))) float lds[];
    cg::grid_group grid = cg::this_grid();
    volatile LAS unsigned* st = (volatile LAS unsigned*)((LAS unsigned char*)lds + LDS_USED);
    if (threadIdx.x < 2) st[threadIdx.x] = 0u;
    __syncthreads();
    { const Ph e = g_prog[0]; run_phase(p, e.kind, e.layer, e.f, lds, blockIdx.x, gridDim.x); }
    if (blockIdx.x == 0) { unsigned* bw = (unsigned*)(p.ws + WS_BAR); for (int i = threadIdx.x; i < XCD_BAR_WORDS; i += NTHR) bw[i] = 0u; }
    grid.sync();
    const XcdBarrier bar = xcd_barrier_post((unsigned*)(p.ws + WS_BAR), st);
    for (int ph = 1; ph < NPH; ++ph) {
        const Ph e = g_prog[ph];
        run_phase(p, e.kind, e.layer, e.f, lds, blockIdx.x, gridDim.x);
        if (ph + 1 < NPH) xcd_barrier(bar);
    }
}
#define K_MAIN k_mega
#endif

extern "C" void kernel_launch(void* const* d_in, const int* in_sizes, int n_in, void* d_out, int out_size, void* d_ws, size_t ws_size, hipStream_t stream) {
    static int grid = 0;
    if (grid == 0) {
        if (n_in != 17 || in_sizes[0] != T * DM || out_size != T * DM || ws_size < WS_END) { fprintf(stderr, "kernel_launch: unexpected shapes/ws (n_in %d, ws %zu)\n", n_in, ws_size); grid = -1; return; }
        int dev = 0, cus = 0, per_cu = 0;
        (void)hipGetDevice(&dev); (void)hipDeviceGetAttribute(&cus, hipDeviceAttributeMultiprocessorCount, dev);
        (void)hipFuncSetAttribute((const void*)K_MAIN, hipFuncAttributeMaxDynamicSharedMemorySize, LDS_BYTES);
        (void)hipOccupancyMaxActiveBlocksPerMultiprocessor(&per_cu, (const void*)K_MAIN, NTHR, LDS_BYTES);
        if (per_cu < 1) per_cu = 1;
        if (per_cu > 1) per_cu = 1;
        grid = cus * per_cu;
        (void)hipGetLastError();
    }
    if (grid < 0) return;
    P p{};
    const float** pp = (const float**)&p;
    for (int i = 0; i < 17; ++i) pp[i] = (const float*)d_in[i];
    p.out = (float*)d_out; p.ws = (unsigned char*)d_ws;
#if MEGA
    void* args[] = {&p};
    hipError_t e = hipLaunchCooperativeKernel((const void*)k_mega, dim3(grid), dim3(NTHR), args, LDS_BYTES, stream);
    if (e != hipSuccess) fprintf(stderr, "cooperative launch failed: %s (grid %d)\n", hipGetErrorString(e), grid);
#else
    for (int ph = 0; ph < NPH; ++ph) hipLaunchKernelGGL(k_one, dim3(grid * 4), dim3(NTHR), LDS_BYTES, stream, p, ph);
#endif
}
```
